# Optimizing an MI355X kernel written in HIP

```python
import jax, jax.numpy as jnp
from jax import lax
import numpy as np

D_MODEL = 1024
BATCH = 4
SEQ = 4096
DEPTH = 4

GRID_W = 64
CTX_LEN = 256
N_MIXERS = 3
EPS = 1e-6
N_MOD = 6
N_HEADS = 16
HEAD_DIM = D_MODEL // N_HEADS
N_KV_HEADS = 4
Q_GROUP = N_HEADS // N_KV_HEADS
Q_BLOCK = 128
ROPE_THETA = 10000.0
POOL_WINDOWS = (2, 4, 8, 16)
N_POOL_GROUPS = len(POOL_WINDOWS)
POOL_GROUP_DIM = D_MODEL // N_POOL_GROUPS
SGU_CHUNK = 128
SGU_WIDTH = D_MODEL
SGU_GROUPS = 8
SGU_GROUP_DIM = SGU_WIDTH // SGU_GROUPS
FFN_HIDDEN = 2816
CONV_WIDTH = 3

kernel_name = "hybrid_interleaved_diffusion_trunk"


def rmsnorm(x, g):
    xf = x.astype(jnp.float32)
    y = xf * lax.rsqrt(jnp.mean(xf * xf, axis=-1, keepdims=True) + EPS)
    return (y * g.astype(jnp.float32)).astype(x.dtype)


def modulation(vec, w, b):
    mod = (jax.nn.silu(vec) @ w + b)[:, None, :]
    return jnp.split(mod, N_MOD, axis=-1)


def modulate(h, shift, scale):
    return h * (1 + scale) + shift


def axial_tables(length, dtype):
    rows = length // GRID_W
    row = jnp.repeat(jnp.arange(rows), GRID_W).astype(jnp.float32)
    col = jnp.tile(jnp.arange(GRID_W), rows).astype(jnp.float32)
    n_freq = HEAD_DIM // 4
    freqs = ROPE_THETA ** (-jnp.arange(n_freq, dtype=jnp.float32) / n_freq)
    ang_r = row[:, None] * freqs
    ang_c = col[:, None] * freqs
    tab = lambda a: (jnp.cos(a)[None, :, None, :].astype(dtype), jnp.sin(a)[None, :, None, :].astype(dtype))
    return tab(ang_r), tab(ang_c)


def _rotate(u, cos, sin):
    n = u.shape[-1] // 2
    u1, u2 = u[..., :n], u[..., n:]
    return jnp.concatenate([u1 * cos - u2 * sin, u2 * cos + u1 * sin], axis=-1)


def rope_2d(x, tables):
    (cr, sr), (cc, sc) = tables
    half = HEAD_DIM // 2
    return jnp.concatenate([_rotate(x[..., :half], cr, sr), _rotate(x[..., half:], cc, sc)], axis=-1)


def attend(q, k, v):
    s = jnp.einsum('bqkgd,bskd->bkgqs', q, k).astype(jnp.float32) * (HEAD_DIM ** -0.5)
    p = jax.nn.softmax(s, axis=-1).astype(v.dtype)
    return jnp.einsum('bkgqs,bskd->bqkgd', p, v)


def attention_mixer(hx, hc, wqkv, q_gain, k_gain, wo, need_ctx):
    B, L, _ = hx.shape
    Lc = hc.shape[1]
    nq, nk = N_HEADS * HEAD_DIM, N_KV_HEADS * HEAD_DIM

    def project(h):
        qkv = h @ wqkv
        n = h.shape[1]
        q = qkv[..., :nq].reshape(B, n, N_HEADS, HEAD_DIM)
        k = qkv[..., nq:nq + nk].reshape(B, n, N_KV_HEADS, HEAD_DIM)
        v = qkv[..., nq + nk:].reshape(B, n, N_KV_HEADS, HEAD_DIM)
        return rmsnorm(q, q_gain), rmsnorm(k, k_gain), v

    qx, kx, vx = project(hx)
    qc, kc, vc = project(hc)
    tables = axial_tables(L, hx.dtype)
    qx, kx = rope_2d(qx, tables), rope_2d(kx, tables)

    k_all = jnp.concatenate([kc, kx], axis=1)
    v_all = jnp.concatenate([vc, vx], axis=1)
    nb = L // Q_BLOCK
    qb = qx.reshape(B, nb, Q_BLOCK, N_KV_HEADS, Q_GROUP, HEAD_DIM).transpose(1, 0, 2, 3, 4, 5)
    ob = lax.map(lambda q: attend(q, k_all, v_all), qb)
    ox = ob.transpose(1, 0, 2, 3, 4, 5).reshape(B, L, nq) @ wo
    if not need_ctx:
        return ox, None
    oc = attend(qc.reshape(B, Lc, N_KV_HEADS, Q_GROUP, HEAD_DIM), kc, vc).reshape(B, Lc, nq) @ wo
    return ox, oc


def pool_mixer(h, w, b, scale):
    B, L, C = h.shape
    cs = jnp.cumsum(h.astype(jnp.float32), axis=1)
    cs = jnp.concatenate([jnp.zeros((B, 1, C), jnp.float32), cs], axis=1)
    t = jnp.arange(L)
    outs = []
    for g, win in enumerate(POOL_WINDOWS):
        lo = jnp.maximum(t - win // 2, 0)
        hi = jnp.minimum(t + win - win // 2 - 1, L - 1)
        sl = cs[..., g * POOL_GROUP_DIM:(g + 1) * POOL_GROUP_DIM]
        s = jnp.take(sl, hi + 1, axis=1) - jnp.take(sl, lo, axis=1)
        cnt = (hi - lo + 1).astype(jnp.float32)[None, :, None]
        outs.append(s / cnt)
    pooled = jnp.concatenate(outs, axis=-1).astype(h.dtype) - h
    y = jnp.einsum('blgd,gde->blge', pooled.reshape(B, L, N_POOL_GROUPS, POOL_GROUP_DIM), w).reshape(B, L, C) + b
    return y * scale


def sgu_mixer(h, w_in, v_gain, w_s, b_s, w_out):
    B, L, _ = h.shape
    z = jax.nn.gelu(h @ w_in)
    u, v = z[..., :SGU_WIDTH], z[..., SGU_WIDTH:]
    v = rmsnorm(v, v_gain)
    nc = L // SGU_CHUNK
    vv = v.reshape(B, nc, SGU_CHUNK, SGU_GROUPS, SGU_GROUP_DIM)
    y = jnp.einsum('gmn,bcnge->bcmge', w_s, vv) + b_s.T[None, None, :, :, None]
    return (u * y.reshape(B, L, SGU_WIDTH)) @ w_out


def dwconv(a, w, b):
    L = a.shape[1]
    p = CONV_WIDTH // 2
    ap = jnp.pad(a, ((0, 0), (p, CONV_WIDTH - 1 - p), (0, 0)))
    return sum(ap[:, k:k + L] * w[k] for k in range(CONV_WIDTH)) + b


def conv_ffn(h, w_up, conv_w, conv_b, w_down):
    a = dwconv(h @ w_up, conv_w, conv_b)
    val, gate = a[..., :FFN_HIDDEN], a[..., FFN_HIDDEN:]
    return (jax.nn.silu(gate) * val) @ w_down


def setup_inputs(seed: int = 0) -> dict:
    key = jax.random.key(seed)
    ks = iter(jax.random.split(key, 32))
    D, F = D_MODEL, FFN_HIDDEN
    n_a = len(range(0, DEPTH, N_MIXERS))
    n_b = len(range(1, DEPTH, N_MIXERS))
    n_c = len(range(2, DEPTH, N_MIXERS))
    nrm = lambda shape, s: jax.random.normal(next(ks), shape, jnp.float32) * s
    gain = lambda shape: 1.0 + nrm(shape, 0.02)
    qkv_w = (N_HEADS + 2 * N_KV_HEADS) * HEAD_DIM
    return {
        "x": nrm((BATCH, SEQ, D), 1.0),
        "c": nrm((BATCH, D), 1.0),
        "ctx": nrm((BATCH, CTX_LEN, D), 1.0),
        "c_ctx": nrm((D,), 1.0),
        "ada_w": nrm((DEPTH, D, N_MOD * D), 0.5 * D ** -0.5),
        "ada_b": nrm((DEPTH, N_MOD * D), 0.02),
        "norm_w": gain((DEPTH, 2, D)),
        "attn_wqkv": nrm((n_a, D, qkv_w), D ** -0.5),
        "attn_q_gain": gain((n_a, HEAD_DIM)),
        "attn_k_gain": gain((n_a, HEAD_DIM)),
        "attn_wo": nrm((n_a, N_HEADS * HEAD_DIM, D), (N_HEADS * HEAD_DIM) ** -0.5),
        "pool_w": nrm((n_b, N_POOL_GROUPS, POOL_GROUP_DIM, POOL_GROUP_DIM), POOL_GROUP_DIM ** -0.5),
        "pool_b": nrm((n_b, D), 0.02),
        "pool_scale": 1.0 + nrm((n_b, D), 0.1),
        "sgu_w_in": nrm((n_c, D, 2 * SGU_WIDTH), D ** -0.5),
        "sgu_v_gain": gain((n_c, SGU_WIDTH)),
        "sgu_w_s": nrm((n_c, SGU_GROUPS, SGU_CHUNK, SGU_CHUNK), SGU_CHUNK ** -0.5),
        "sgu_b_s": 1.0 + nrm((n_c, SGU_GROUPS, SGU_CHUNK), 0.1),
        "sgu_w_out": nrm((n_c, SGU_WIDTH, D), SGU_WIDTH ** -0.5),
        "ffn_w_up": nrm((DEPTH, D, 2 * F), D ** -0.5),
        "ffn_conv_w": nrm((DEPTH, CONV_WIDTH, 2 * F), CONV_WIDTH ** -0.5),
        "ffn_conv_b": nrm((DEPTH, 2 * F), 0.02),
        "ffn_w_down": nrm((DEPTH, F, D), F ** -0.5),
        "final_norm": gain((D,)),
    }


def reference(x, c, ctx, c_ctx, ada_w, ada_b, norm_w, attn_wqkv, attn_q_gain, attn_k_gain, attn_wo,
              pool_w, pool_b, pool_scale, sgu_w_in, sgu_v_gain, sgu_w_s, sgu_b_s, sgu_w_out,
              ffn_w_up, ffn_conv_w, ffn_conv_b, ffn_w_down, final_norm):
    xc = ctx
    c_vec = c_ctx[None, :]
    for i in range(DEPTH):
        kind, j, last = i % N_MIXERS, i // N_MIXERS, i == DEPTH - 1
        sh1, sc1, g1, sh2, sc2, g2 = modulation(c, ada_w[i], ada_b[i])
        csh1, csc1, cg1, csh2, csc2, cg2 = modulation(c_vec, ada_w[i], ada_b[i])
        hx = modulate(rmsnorm(x, norm_w[i, 0]), sh1, sc1)
        hc = modulate(rmsnorm(xc, norm_w[i, 0]), csh1, csc1)
        if kind == 0:
            dx, dc = attention_mixer(hx, hc, attn_wqkv[j], attn_q_gain[j], attn_k_gain[j], attn_wo[j],
                                     need_ctx=not last)
        elif kind == 1:
            dx = pool_mixer(hx, pool_w[j], pool_b[j], pool_scale[j])
            dc = None if last else pool_mixer(hc, pool_w[j], pool_b[j], pool_scale[j])
        else:
            dx = sgu_mixer(hx, sgu_w_in[j], sgu_v_gain[j], sgu_w_s[j], sgu_b_s[j], sgu_w_out[j])
            dc = None if last else sgu_mixer(hc, sgu_w_in[j], sgu_v_gain[j], sgu_w_s[j], sgu_b_s[j], sgu_w_out[j])
        x = x + g1 * dx
        hx2 = modulate(rmsnorm(x, norm_w[i, 1]), sh2, sc2)
        x = x + g2 * conv_ffn(hx2, ffn_w_up[i], ffn_conv_w[i], ffn_conv_b[i], ffn_w_down[i])
        if not last:
            xc = xc + cg1 * dc
            hc2 = modulate(rmsnorm(xc, norm_w[i, 1]), csh2, csc2)
            xc = xc + cg2 * conv_ffn(hc2, ffn_w_up[i], ffn_conv_w[i], ffn_conv_b[i], ffn_w_down[i])
    return rmsnorm(x, final_norm)
```

```cpp
#include <hip/hip_runtime.h>
#include <hip/hip_cooperative_groups.h>
#include <cstdio>
#include <cstdint>
namespace cg = cooperative_groups;

constexpr int D = 1024, NB = 4, L = 4096, LC = 256, DEPTH = 4;
constexpr int NLAT = NB * L, NCTX = NB * LC, NTOK = NLAT + NCTX;
constexpr int FF = 2816, FF2 = 5632;
constexpr int NH = 16, HD = 64, NKV = 4, QKVW = 1536;
constexpr float EPS = 1e-6f;
constexpr int NT = 512;
constexpr int NWAVES = 8;
constexpr int RP = 1152;
constexpr int RPP = 288;

#define LAS __attribute__((address_space(3)))
typedef unsigned short bf16_t;
typedef short bf16x8 __attribute__((ext_vector_type(8)));
typedef float f32x4 __attribute__((ext_vector_type(4)));
typedef unsigned u32x4 __attribute__((ext_vector_type(4)));
typedef unsigned u32x2 __attribute__((ext_vector_type(2)));

__device__ __forceinline__ unsigned f2bf(float f) { unsigned u = __builtin_bit_cast(unsigned, f); return (u + 0x7fffu + ((u >> 16) & 1u)) >> 16; }
typedef float f32x2_c __attribute__((ext_vector_type(2))); typedef __bf16 bf16x2_c __attribute__((ext_vector_type(2)));
__device__ __forceinline__ unsigned pk2(float lo, float hi) { f32x2_c v = {lo, hi}; bf16x2_c b = __builtin_convertvector(v, bf16x2_c); return __builtin_bit_cast(unsigned, b); }
typedef _Float16 h16x2_c __attribute__((ext_vector_type(2)));
__device__ __forceinline__ unsigned pkh2(float lo, float hi) { unsigned a, b; asm("v_cvt_f16_f32 %0, %1" : "=v"(a) : "v"(lo)); asm("v_cvt_f16_f32 %0, %1" : "=v"(b) : "v"(hi));
    return (a & 0xffffu) | (b << 16); }
__device__ __forceinline__ f32x4 unpkh4(u32x2 w) {
    float a, b, c, d; const unsigned hx = w.x >> 16, hy = w.y >> 16;
    asm("v_cvt_f32_f16 %0, %1" : "=v"(a) : "v"(w.x)); asm("v_cvt_f32_f16 %0, %1" : "=v"(b) : "v"(hx));
    asm("v_cvt_f32_f16 %0, %1" : "=v"(c) : "v"(w.y)); asm("v_cvt_f32_f16 %0, %1" : "=v"(d) : "v"(hy));
    return (f32x4){a, b, c, d};
}
__device__ __forceinline__ float bf2f(unsigned short b) { return __builtin_bit_cast(float, (unsigned)b << 16); }

namespace pg8 {
constexpr int BM = 256, BK = 64, HALF = 128, HTB = HALF * BK * 2, STAGE_BYTES = 8 * HTB, NXCD = 8, WGM = 8;
__host__ __device__ __forceinline__ int lds_byte(int r, int c) { const int st = (r >> 4) * 2 + (c >> 5), rr = r & 15, cc = c & 31, ob = rr * 64 + cc * 2; return st * 1024 + (ob ^ (((ob >> 9) & 1) << 5)); }
__host__ __device__ __forceinline__ void stage_rc(int b, int& R, int& C) { const int st = b / 1024, sb = b % 1024, swz = sb ^ (((sb >> 9) & 1) << 5); R = (st >> 1) * 16 + swz / 64; C = (st & 1) * 32 + (swz % 64) / 2; }

struct Unit { int pm, pn; int kt0, nkt  ; int rng  ; int role  ; };
struct Gemm { const bf16_t* A; const bf16_t* Bt; int lda, ldb, K; size_t a_pn_step, b_unit_step, b_half_step; };

struct StaticOrder {
    int nM, nN, nwg, G, c;
    __host__ __device__ __forceinline__ void init(int M, int N, int G_, int c_) { nM = M / BM; nN = N / BM; nwg = nM * nN; G = G_; c = c_; }
    __host__ __device__ __forceinline__ bool next(int i, Unit& u) const {
        const long Lx = (long)i * G + c; if (Lx >= nwg) return false;
        int wgid = (int)Lx; { const int q = nwg / NXCD, r = nwg % NXCD, xcd = wgid % NXCD, off = wgid / NXCD; wgid = (xcd < r ? xcd * (q + 1) : r * (q + 1) + (xcd - r) * q) + off; }
        const int nig = WGM * nN, gid = wgid / nig, fm = gid * WGM, gsz = (nM - fm) < WGM ? (nM - fm) : WGM;
        u.pm = fm + ((wgid % nig) % gsz); u.pn = (wgid % nig) / gsz; u.kt0 = 0; u.nkt = 0; u.rng = 0; u.role = 0; return true;
    }
};


struct StreamOrder {
    int nN, nkt, nblk, r, s, e;
    int mode;
    __host__ __device__ __forceinline__ void init(int M, int N, int K, int G, int c, int mode_) { mode = mode_; const int nM = M / BM; nN = N / BM; nkt = K / BK; nblk = nM * nN / 16;
        const int x = c % 8, i = c / 8; r = (G == 256) ? (2 * x + (i & 1)) + 16 * (i >> 1) : c;
        const long q = (long)nM * nN * nkt / 4; s = 4 * (int)((long)r * q / G); e = 4 * (int)((long)(r + 1) * q / G); }
    __host__ __device__ __forceinline__ bool next(int i, Unit& u) const {
        const bool has_tail = (s % nkt) != 0;
        if (mode == 0) { if (i > 0 || !has_tail) return false; } else if (has_tail) ++i;
        int p = s; for (int k = 0; k < i; ++k) { const int ue = (p / nkt + 1) * nkt; p = ue < e ? ue : e; }
        if (p >= e) return false;
        const int ui = p / nkt, kt0 = p % nkt, ue = (ui + 1) * nkt, pe = ue < e ? ue : e;
        const int k = ui / nblk, j = ui % nblk, ncb = nN / 4, jb = j / ncb, jc = j % ncb;
        u.pm = 4 * jb + (k & 3); u.pn = 4 * jc + (k >> 2); u.kt0 = kt0; u.nkt = pe - p; u.rng = r; u.role = (kt0 == 0 && pe == ue) ? 0 : (kt0 > 0 ? 1 : 2);
        return true;
    }
};

template <class Epi, class Sched, bool ALIGN_EPI>
__device__ __forceinline__ void gemm_phase(LAS unsigned char* lds, const Gemm g, const Sched& S, const Epi& E) {
    int tid = threadIdx.x; asm volatile("" : "+v"(tid));
    const int wid = __builtin_amdgcn_readfirstlane(tid >> 6), lane = tid & 63, wr = wid >> 2, wc = wid & 3, fr = lane & 15, fq = lane >> 4;
    int K = g.K; asm volatile("" : "+s"(K));
    const int nt_full = K / BK;
    unsigned voffA[2], voffB[2];
#pragma unroll
    for (int i = 0; i < 2; ++i) { int R, C; stage_rc(tid * 16 + i * 8192, R, C); const int Rb = Epi::brow(R);
        voffA[i] = (unsigned)(R * g.lda + C) * 2u; voffB[i] = (unsigned)(Rb * g.ldb + C) * 2u; }
    const size_t kstep = (size_t)(BK * 2);
    const size_t hstepA = (size_t)HALF * g.lda * 2, tstepA = 2 * hstepA, hstepB = g.b_half_step;
    const unsigned ldsw = (unsigned)wid * 1024u;
    const int aoff = lds_byte(wr * 64 + fr, fq * 8), boff = lds_byte(wc * 32 + fr, fq * 8);
#define PG8_SA(b, h) (((b) * 2 + (h)) * HTB)
#define PG8_SB(b, h) ((4 + (b) * 2 + (h)) * HTB)
#define PG8_STAGE(bufoff, gbase, voff) do { _Pragma("unroll") for (int _i = 0; _i < 2; ++_i) \
        __builtin_amdgcn_global_load_lds((const unsigned*)((const char*)(gbase) + (voff)[_i]), (LAS unsigned*)(lds + (bufoff) + ldsw + _i * 8192), 16, 0, 0); } while (0)
#define PG8_LDA(dst, b, h) do { _Pragma("unroll") for (int m = 0; m < 4; ++m) _Pragma("unroll") for (int k = 0; k < 2; ++k) dst[m][k] = *(const LAS bf16x8*)(lds + PG8_SA(b, h) + aoff + m * 2048 + k * 1024); } while (0)
#define PG8_LDB(dst, b, h) do { _Pragma("unroll") for (int n = 0; n < 2; ++n) _Pragma("unroll") for (int k = 0; k < 2; ++k) dst[n][k] = *(const LAS bf16x8*)(lds + PG8_SB(b, h) + boff + n * 2048 + k * 1024); } while (0)
#define PG8_MMA(ai, bj, At, Bt) do { __builtin_amdgcn_s_setprio(1); _Pragma("unroll") for (int m = 0; m < 4; ++m) _Pragma("unroll") for (int n = 0; n < 2; ++n) _Pragma("unroll") for (int k = 0; k < 2; ++k) \
        acc[ai][bj][m][n] = __builtin_amdgcn_mfma_f32_16x16x32_bf16(Bt[n][k], At[m][k], acc[ai][bj][m][n], 0, 0, 0); __builtin_amdgcn_s_setprio(0); } while (0)
#define PG8_WAIT_V(n) asm volatile("s_waitcnt vmcnt(" #n ")" ::: "memory")
#define PG8_WAIT_L(n) asm volatile("s_waitcnt lgkmcnt(" #n ")" ::: "memory")
#define PG8_BAR __builtin_amdgcn_s_barrier()
#define PG8_SCHED __builtin_amdgcn_sched_barrier(0)
    Unit cur, nxt; int ui = 0;
    if (!S.next(0, cur)) return;
    f32x4 acc[2][2][4][2];
#pragma unroll
    for (int a = 0; a < 2; ++a)
#pragma unroll
        for (int b = 0; b < 2; ++b)
#pragma unroll
            for (int m = 0; m < 4; ++m)
#pragma unroll
                for (int n = 0; n < 2; ++n) acc[a][b][m][n] = (f32x4){0.f, 0.f, 0.f, 0.f};
    bf16x8 At[4][2], B0[2][2], B1[2][2];
    const char* cA = (const char*)g.A + (size_t)cur.pm * tstepA + (size_t)cur.pn * g.a_pn_step + (size_t)cur.kt0 * kstep; const char* cB = (const char*)g.Bt + (size_t)cur.pn * g.b_unit_step + (size_t)cur.kt0 * kstep;
    int nt = cur.nkt ? cur.nkt : nt_full;
    { int l2 = threadIdx.x; asm volatile("" : "+v"(l2)); l2 &= 63; E.prefetch(cur, wid, l2, 0); }
    PG8_STAGE(PG8_SB(0, 0), cB, voffB); PG8_STAGE(PG8_SB(0, 1), cB + hstepB, voffB); PG8_STAGE(PG8_SA(0, 0), cA, voffA); PG8_STAGE(PG8_SA(0, 1), cA + hstepA, voffA);
    if (wr == 1) PG8_BAR;
    PG8_WAIT_V(2); PG8_BAR;
    PG8_STAGE(PG8_SB(1, 0), cB + kstep, voffB); PG8_STAGE(PG8_SA(1, 0), cA + kstep, voffA); PG8_STAGE(PG8_SB(1, 1), cB + hstepB + kstep, voffB);
    PG8_WAIT_V(6); PG8_BAR;
    for (;;) {
        const bool has_next = S.next(ui + 1, nxt);
        const char* nA = has_next ? (const char*)g.A + (size_t)nxt.pm * tstepA + (size_t)nxt.pn * g.a_pn_step + (size_t)nxt.kt0 * kstep : cA; const char* nB = has_next ? (const char*)g.Bt + (size_t)nxt.pn * g.b_unit_step + (size_t)nxt.kt0 * kstep : cB;
        for (int t = 0; t < nt; t += 2) {
            const bool last = (t == nt - 2);
            const char* a1 = cA + (size_t)(t + 1) * kstep;
            const char* a2 = last ? nA : cA + (size_t)(t + 2) * kstep; const char* b2 = last ? nB : cB + (size_t)(t + 2) * kstep;
            const char* a3 = a2 + kstep; const char* b3 = b2 + kstep;
            PG8_LDB(B0, 0, 0); PG8_LDB(B1, 0, 1); PG8_SCHED; PG8_LDA(At, 0, 0); PG8_STAGE(PG8_SA(1, 1), a1 + hstepA, voffA);
            PG8_WAIT_V(8); PG8_WAIT_L(0); PG8_BAR; PG8_MMA(0, 0, At, B0); PG8_MMA(0, 1, At, B1); PG8_BAR; PG8_SCHED;
            PG8_LDA(At, 0, 1); PG8_STAGE(PG8_SB(0, 0), b2, voffB); PG8_STAGE(PG8_SB(0, 1), b2 + hstepB, voffB); PG8_STAGE(PG8_SA(0, 0), a2, voffA);
            PG8_WAIT_V(8); PG8_WAIT_L(0); PG8_BAR; PG8_MMA(1, 0, At, B0); PG8_MMA(1, 1, At, B1); PG8_BAR; PG8_SCHED;
            PG8_LDB(B0, 1, 0); PG8_LDB(B1, 1, 1); PG8_SCHED; PG8_LDA(At, 1, 0); PG8_STAGE(PG8_SA(0, 1), a2 + hstepA, voffA);
            PG8_WAIT_V(8); PG8_WAIT_L(0); PG8_BAR; PG8_MMA(0, 0, At, B0); PG8_MMA(0, 1, At, B1); PG8_BAR; PG8_SCHED;
            PG8_LDA(At, 1, 1); PG8_STAGE(PG8_SB(1, 0), b3, voffB); PG8_STAGE(PG8_SB(1, 1), b3 + hstepB, voffB); PG8_STAGE(PG8_SA(1, 0), a3, voffA);
            PG8_WAIT_V(8); PG8_WAIT_L(0); PG8_BAR; PG8_MMA(1, 0, At, B0); PG8_MMA(1, 1, At, B1); PG8_BAR; PG8_SCHED;
        }
        if constexpr (ALIGN_EPI) { if (wr == 0) PG8_BAR; }
        { int t2 = threadIdx.x; asm volatile("" : "+v"(t2));
          const int wid2 = __builtin_amdgcn_readfirstlane(t2 >> 6), lane2 = t2 & 63; E(acc, cur, wid2 >> 2, wid2 & 3, lane2 & 15, lane2 >> 4, ui & 1); }
        if (!has_next) break;
#pragma unroll
        for (int a = 0; a < 2; ++a)
#pragma unroll
            for (int b = 0; b < 2; ++b)
#pragma unroll
                for (int m = 0; m < 4; ++m)
#pragma unroll
                    for (int n = 0; n < 2; ++n) acc[a][b][m][n] = (f32x4){0.f, 0.f, 0.f, 0.f};
        cur = nxt; cA = nA; cB = nB; ++ui; nt = cur.nkt ? cur.nkt : nt_full;
        { int l2 = threadIdx.x; asm volatile("" : "+v"(l2)); l2 &= 63; E.prefetch(cur, wid, l2, ui & 1); }
        if constexpr (ALIGN_EPI) { if (wr == 1) PG8_BAR; }
    }
    PG8_WAIT_V(0);
    if constexpr (!ALIGN_EPI) { if (wr == 0) PG8_BAR; }
    PG8_BAR;
#undef PG8_SA
#undef PG8_SB
#undef PG8_STAGE
#undef PG8_LDA
#undef PG8_LDB
#undef PG8_MMA
#undef PG8_WAIT_V
#undef PG8_WAIT_L
#undef PG8_BAR
#undef PG8_SCHED
}
}

namespace attn_body {
using s16x4 = __attribute__((ext_vector_type(4))) short;
using f32x16 = __attribute__((ext_vector_type(16))) float;
constexpr int DM = RP, KP = 256, NW = 8, QBLK = 32, QB = 256, KVBLK = 64;
__device__ __forceinline__ int crow(int r, int hi) { return (r & 3) + 8 * (r >> 2) + 4 * hi; }
#define SBAR() __builtin_amdgcn_sched_barrier(0)
constexpr int NSLOT = 3, SLOTB = 8192;
constexpr int LDS_K = 0, LDS_V = NSLOT * SLOTB, LDS_WS = 2 * NSLOT * SLOTB, LDS_OST = LDS_WS + NW * 64 * 4, LDS_QST = LDS_OST + NW * 4096, LDS_BYTES_A = LDS_QST + NW * 4096;
constexpr float C2 = 0.125f * 1.4426950408889634f;
__device__ __forceinline__ void glds16(const void* gsrc, unsigned lds_dst) { unsigned keep;
    asm volatile("s_mov_b32 %0, m0\n\ts_mov_b32 m0, %2\n\ts_nop 0\n\tglobal_load_lds_dwordx4 %1, off\n\ts_mov_b32 m0, %0" : "=&s"(keep) : "v"(gsrc), "s"(lds_dst) : "memory"); }
typedef float f32x2_t __attribute__((ext_vector_type(2))); typedef __bf16 bf16x2_t __attribute__((ext_vector_type(2)));
__device__ __forceinline__ unsigned cvtpk_s(float lo, float hi) { f32x2_t v = {lo, hi}; bf16x2_t b = __builtin_convertvector(v, bf16x2_t); return __builtin_bit_cast(unsigned, b); }
#define WAIT_BAR(N) asm volatile("s_waitcnt vmcnt(" #N ") lgkmcnt(0)\n\ts_barrier" ::: "memory")
__device__ __forceinline__ void qkt(f32x16& p0, f32x16& p1, const char* Kslot, const bf16x8* qr, const f32x16& negm, int r32, int hi) {
    const int kb0 = r32 * 128 + ((hi ^ ((r32 >> 1) & 7)) * 16);
#pragma unroll
    for (int d0 = 0; d0 < 4; ++d0) {
        const bf16x8 b0 = *reinterpret_cast<const bf16x8*>(Kslot + (kb0 ^ (32 * d0)));
        const bf16x8 b1 = *reinterpret_cast<const bf16x8*>(Kslot + (kb0 ^ (32 * d0)) + 4096);
        if (d0 == 0) { p0 = __builtin_amdgcn_mfma_f32_32x32x16_bf16(b0, qr[0], negm, 0, 0, 0); p1 = __builtin_amdgcn_mfma_f32_32x32x16_bf16(b1, qr[0], negm, 0, 0, 0); }
        else { p0 = __builtin_amdgcn_mfma_f32_32x32x16_bf16(b0, qr[d0], p0, 0, 0, 0); p1 = __builtin_amdgcn_mfma_f32_32x32x16_bf16(b1, qr[d0], p1, 0, 0, 0); } }
}
typedef __attribute__((address_space(3))) const char* lds_cptr;
typedef short v4i16_t __attribute__((ext_vector_type(4)));
#define KLD(p) (*(const __attribute__((address_space(3))) bf16x8*)(p))
__device__ __forceinline__ void kload2(bf16x8* kf, lds_cptr kbase, int kb0, int slot, int j) { const lds_cptr kp = kbase + ((kb0 ^ (32 * j)) + slot); kf[2 * j] = KLD(kp); kf[2 * j + 1] = KLD(kp + 4096); }
__device__ __forceinline__ void kload8(bf16x8* kf, lds_cptr kbase, int kb0, int slot) { kload2(kf, kbase, kb0, slot, 0); kload2(kf, kbase, kb0, slot, 1); kload2(kf, kbase, kb0, slot, 2); kload2(kf, kbase, kb0, slot, 3); }
__device__ __forceinline__ s16x4 vtr(lds_cptr p) { return __builtin_bit_cast(s16x4, __builtin_amdgcn_ds_read_tr16_b64_v4i16((__attribute__((address_space(3))) v4i16_t*)p)); }
__device__ __forceinline__ void pv(f32x16* o, int vb, bf16x8 pa0, bf16x8 pa1, bf16x8 pa2, bf16x8 pa3) {
#pragma unroll
    for (int d0 = 0; d0 < 2; ++d0) { s16x4 lo[4], hi[4];
#pragma unroll
        for (int ks = 0; ks < 4; ++ks) {
            asm volatile("ds_read_b64_tr_b16 %0,%1 offset:%c2" : "=&v"(lo[ks]) : "v"(vb), "i"(d0 * 4096 + ks * 1024) : "memory");
            asm volatile("ds_read_b64_tr_b16 %0,%1 offset:%c2" : "=&v"(hi[ks]) : "v"(vb), "i"(d0 * 4096 + ks * 1024 + 512) : "memory"); }
        asm volatile("s_waitcnt lgkmcnt(0)" ::: "memory"); SBAR();
#define PK(k) (bf16x8){lo[k][0], lo[k][1], lo[k][2], lo[k][3], hi[k][0], hi[k][1], hi[k][2], hi[k][3]}
        o[d0] = __builtin_amdgcn_mfma_f32_32x32x16_bf16(pa0, PK(0), o[d0], 0, 0, 0);
        o[d0] = __builtin_amdgcn_mfma_f32_32x32x16_bf16(pa1, PK(1), o[d0], 0, 0, 0);
        o[d0] = __builtin_amdgcn_mfma_f32_32x32x16_bf16(pa2, PK(2), o[d0], 0, 0, 0);
        o[d0] = __builtin_amdgcn_mfma_f32_32x32x16_bf16(pa3, PK(3), o[d0], 0, 0, 0);
#undef PK
    }
}
__device__ __forceinline__ void attn_unit(int qrow0, int h, int nh, int krow0, int kvh, int NT, float m2, bf16_t* Q, const bf16_t* __restrict__ K, const bf16_t* __restrict__ V, char* shm) {
    int tid = threadIdx.x; asm volatile("" : "+v"(tid));
    const int lane = tid & 63, r32 = lane & 31, hi = lane >> 5; const int wid = __builtin_amdgcn_readfirstlane(tid >> 6);
    const bf16_t* Qw = Q + (size_t)(qrow0 + wid * QBLK) * DM + h * 64;
    const bf16_t* Kh = K + (size_t)krow0 * KP + kvh * 64; const bf16_t* Vh = V + (size_t)krow0 * KP + kvh * 64;
    const unsigned lds0 = (unsigned)(uintptr_t)shm;
    float* wsf = (float*)(shm + LDS_WS) + wid * 64;
    const int kkey = 8 * wid + (lane >> 3);
    const bf16_t* ksrc = Kh + (long)kkey * KP + (((lane & 7) ^ ((kkey >> 1) & 7)) * 8);
    const bf16_t* vsrc = Vh + (long)(16 * (wid & 3) + (lane >> 2)) * KP + (wid >> 2) * 32 + (lane & 3) * 8;
    const unsigned kdst = lds0 + LDS_K + wid * 1024, vdst = lds0 + LDS_V + wid * 1024;
#define DMA_K(t, slot) glds16(ksrc + (long)(t) * KVBLK * KP, (unsigned)__builtin_amdgcn_readfirstlane(kdst + (slot)))
#define DMA_V(t, slot) glds16(vsrc + (long)(t) * KVBLK * KP, (unsigned)__builtin_amdgcn_readfirstlane(vdst + (slot)))
    const int TT = nh * NT; int kt3 = 4 % NT, vt1 = 2 % NT;
    const unsigned qst = lds0 + LDS_QST + wid * 4096;
#define DMA_Q(hh) do { const bf16_t* qn_ = Q + (size_t)(qrow0 + wid * QBLK) * DM + (hh) * 64 + (long)r32 * DM + hi * 8; _Pragma("unroll") for (int d0 = 0; d0 < 4; ++d0) glds16(qn_ + d0 * 16, (unsigned)__builtin_amdgcn_readfirstlane(qst + d0 * 1024)); } while (0)
    const int vb0 = (int)(lds0 + LDS_V) + ((lane >> 4) & 1) * 32 + (lane & 3) * 8 + (4 * hi + ((lane & 15) >> 2)) * 64;
    const char* Kbase = shm + LDS_K; bf16x8 kf[8];
    const lds_cptr shm3 = (lds_cptr)shm; const lds_cptr kbase = shm3 + LDS_K; const int kb0 = r32 * 128 + ((hi ^ ((r32 >> 1) & 7)) * 16); const lds_cptr vp0 = shm3 + LDS_V + ((lane >> 4) & 1) * 32 + (lane & 3) * 8 + (4 * hi + ((lane & 15) >> 2)) * 64;
    DMA_K(0, 0); DMA_V(0, 0); DMA_K(1, SLOTB);
    bf16x8 qr[4];
#pragma unroll
    for (int d0 = 0; d0 < 4; ++d0) qr[d0] = *reinterpret_cast<const bf16x8*>(&Qw[(long)r32 * DM + d0 * 16 + hi * 8]);
    float l_reg = 0.f; f32x16 o[2]; o[0] = f32x16{}; o[1] = f32x16{}; f32x16 negm;
#pragma unroll
    for (int r = 0; r < 16; ++r) negm[r] = -m2;
    asm volatile("" : "+v"(negm));
    f32x16 pA0, pA1, pB0, pB1;
    int sl_prev = 0, sl_cur = 0, sl_next = SLOTB;
#define ROT() do { sl_prev = sl_cur; sl_cur = sl_next; sl_next = (sl_next == (NSLOT - 1) * SLOTB) ? 0 : sl_next + SLOTB; } while (0)
    if (nh > 1) DMA_Q(h + 1);
    DMA_K(2, 2 * SLOTB);
    WAIT_BAR(3);
    qkt(pA0, pA1, Kbase, qr, negm, r32, hi);
#pragma unroll
    for (int r = 0; r < 16; ++r) { pA0[r] = __builtin_amdgcn_exp2f(pA0[r]); pA1[r] = __builtin_amdgcn_exp2f(pA1[r]); }
    WAIT_BAR(0);
    DMA_K(3, 0); DMA_V(1, SLOTB);
    ROT();
    kload8(kf, kbase, kb0, sl_cur);
    WAIT_BAR(2);
    s16x4 vlo[8], vhi[8]; u32x4 pw0, pw1, pw2, pw3;
#define PKW(P, B) cvtpk_s(P[B], P[B + 1])
#define PAF(k) __builtin_bit_cast(bf16x8, pw##k)
#define VFR(i) (bf16x8){vlo[i][0], vlo[i][1], vlo[i][2], vlo[i][3], vhi[i][0], vhi[i][1], vhi[i][2], vhi[i][3]}
#define PIN(x) asm volatile("" : "+v"(x))
#define GAPA(MF, A0, A1, A2, A3, W0, W1, PW) do { MF; sacc += A0; sacc += A1; sacc += A2; sacc += A3; PIN(sacc); W0; W1; PIN(PW); SBAR(); } while (0)
#define EX(v) __builtin_amdgcn_exp2f(v)
#define GAPB(MF, X, B) do { MF; X[B] = EX(X[B]); X[B + 1] = EX(X[B + 1]); X[B + 2] = EX(X[B + 2]); X[B + 3] = EX(X[B + 3]); PIN(X); SBAR(); } while (0)
#define VRD(i) do { vlo[i] = vtr(vp_ + (((i) >> 2) * 4096 + ((i) & 3) * 1024)); vhi[i] = vtr(vp_ + (((i) >> 2) * 4096 + ((i) & 3) * 1024 + 512)); } while (0)
#define KRD(G, j) do { if (G) { kload2(kf, kbase, kb0, sl_next, j); SBAR(); } } while (0)
#define MF32(a, b, c) __builtin_amdgcn_mfma_f32_32x32x16_bf16(a, b, c, 0, 0, 0)
#define STEP(C0, C1, P0, P1, t, GK, GV, GL) do { SBAR(); \
    const lds_cptr vp_ = vp0 + sl_prev; \
    VRD(0); SBAR(); float sacc = (P0[0] + P0[1]); \
    GAPA(C0 = MF32(kf[0], qr[0], negm), P0[2], P0[3], P0[4], P0[5],     pw0[0] = PKW(P0, 0), pw0[1] = PKW(P0, 2), pw0); \
    VRD(4); SBAR(); GAPA(C1 = MF32(kf[1], qr[0], negm), P0[6], P0[7], P0[8], P0[9],     pw0[2] = PKW(P0, 4), pw0[3] = PKW(P0, 6), pw0); \
    VRD(1); SBAR(); GAPA(C0 = MF32(kf[2], qr[1], C0),   P0[10], P0[11], P0[12], P0[13], pw1[0] = PKW(P0, 8), pw1[1] = PKW(P0, 10), pw1); \
    VRD(5); SBAR(); GAPA(C1 = MF32(kf[3], qr[1], C1),   P0[14], P0[15], P1[0], P1[1],   pw1[2] = PKW(P0, 12), pw1[3] = PKW(P0, 14), pw1); \
    VRD(2); SBAR(); GAPA(C0 = MF32(kf[4], qr[2], C0),   P1[2], P1[3], P1[4], P1[5],     pw2[0] = PKW(P1, 0), pw2[1] = PKW(P1, 2), pw2); \
    VRD(6); SBAR(); GAPA(C1 = MF32(kf[5], qr[2], C1),   P1[6], P1[7], P1[8], P1[9],     pw2[2] = PKW(P1, 4), pw2[3] = PKW(P1, 6), pw2); \
    VRD(3); SBAR(); GAPA(C0 = MF32(kf[6], qr[3], C0),   P1[10], P1[11], P1[12], P1[13], pw3[0] = PKW(P1, 8), pw3[1] = PKW(P1, 10), pw3); \
    VRD(7); SBAR(); GAPA(C1 = MF32(kf[7], qr[3], C1),   P1[14], P1[15], 0.f, 0.f,       pw3[2] = PKW(P1, 12), pw3[3] = PKW(P1, 14), pw3); \
    l_reg += sacc; \
    if (GK) { DMA_K(kt3, sl_cur); } if (GV) { DMA_V(vt1, sl_next); } kt3 = (kt3 + 1 == NT) ? 0 : kt3 + 1; vt1 = (vt1 + 1 == NT) ? 0 : vt1 + 1; \
    SBAR(); \
    GAPB(o[0] = MF32(PAF(0), VFR(0), o[0]), C0, 0); \
    GAPB(o[1] = MF32(PAF(0), VFR(4), o[1]), C0, 4); \
    KRD(GL, 0); GAPB(o[0] = MF32(PAF(1), VFR(1), o[0]), C0, 8); \
    KRD(GL, 1); GAPB(o[1] = MF32(PAF(1), VFR(5), o[1]), C0, 12); \
    KRD(GL, 2); GAPB(o[0] = MF32(PAF(2), VFR(2), o[0]), C1, 0); \
    KRD(GL, 3); GAPB(o[1] = MF32(PAF(2), VFR(6), o[1]), C1, 4); \
    GAPB(o[0] = MF32(PAF(3), VFR(3), o[0]), C1, 8); \
    GAPB(o[1] = MF32(PAF(3), VFR(7), o[1]), C1, 12); \
    } while (0)
#define FINALIZE(hh) do { \
    { auto rr = __builtin_amdgcn_permlane32_swap(__float_as_uint(l_reg), __float_as_uint(l_reg), false, false); l_reg = __uint_as_float(rr[0]) + __uint_as_float(rr[1]); } \
    if (hi == 0) wsf[32 + r32] = l_reg; asm volatile("s_waitcnt lgkmcnt(0)" ::: "memory"); \
    float rli[16]; \
    _Pragma("unroll") for (int r = 0; r < 16; ++r) rli[r] = __builtin_amdgcn_rcpf(wsf[32 + crow(r, hi)]); \
    bf16_t* Ow = Q + (size_t)(qrow0 + wid * QBLK) * DM + (hh) * 64; \
    { bf16_t* stg = (bf16_t*)(shm + LDS_OST) + wid * 2048; \
      _Pragma("unroll") for (int r = 0; r < 16; ++r) { const int orow = crow(r, hi); \
          _Pragma("unroll") for (int d0 = 0; d0 < 2; ++d0) stg[orow * 64 + d0 * 32 + r32] = (bf16_t)f2bf(o[d0][r] * rli[r]); } \
      asm volatile("s_waitcnt lgkmcnt(0)" ::: "memory"); \
      _Pragma("unroll") for (int i = 0; i < 4; ++i) { const int row = i * 8 + (lane >> 3), ch = lane & 7; const u32x4 v = *(const u32x4*)(stg + row * 64 + ch * 8); *(u32x4*)(Ow + (long)row * DM + ch * 8) = v; } \
      asm volatile("s_waitcnt lgkmcnt(0)" ::: "memory"); } } while (0)
    int t = 1, hcur = h;
    for (int m = 0; m < nh; ++m) {
        const bool lasth = (m == nh - 1); const int lim = lasth ? TT - 5 : (m + 1) * NT - 1;
        for (; t < lim; t += 2) {
            STEP(pB0, pB1, pA0, pA1, t, true, true, true);     WAIT_BAR(2); ROT();
            STEP(pA0, pA1, pB0, pB1, t + 1, true, true, true); WAIT_BAR(2); ROT();
        }
        if (!lasth) {
            STEP(pB0, pB1, pA0, pA1, t, true, true, true);     WAIT_BAR(2); ROT();
#pragma unroll
            for (int d0 = 0; d0 < 4; ++d0) qr[d0] = *(const __attribute__((address_space(3))) bf16x8*)((lds_cptr)shm3 + LDS_QST + wid * 4096 + d0 * 1024 + lane * 16);
            STEP(pA0, pA1, pB0, pB1, t + 1, true, true, true); WAIT_BAR(2); ROT();
            FINALIZE(hcur);
            o[0] = f32x16{}; o[1] = f32x16{}; l_reg = 0.f;
            ++hcur; t += 2;
            if (hcur + 1 < h + nh) DMA_Q(hcur + 1);
        }
    }
#define ENDW(tt) do { if ((tt) + 3 < TT) { WAIT_BAR(2); } else if ((tt) + 2 < TT) { WAIT_BAR(1); } else { WAIT_BAR(0); } } while (0)
    for (; t + 1 < TT; t += 2) {
        STEP(pB0, pB1, pA0, pA1, t, (t + 3 < TT), (t + 1 < TT), (t + 1 < TT));         ENDW(t);     ROT();
        STEP(pA0, pA1, pB0, pB1, t + 1, (t + 4 < TT), (t + 2 < TT), (t + 2 < TT));     ENDW(t + 1); ROT();
    }
    STEP(pB0, pB1, pA0, pA1, TT - 1, false, false, false);
    { float sacc = pB0[0] + pB0[1];
#pragma unroll
      for (int r = 2; r < 16; ++r) sacc += pB0[r];
#pragma unroll
      for (int r = 0; r < 16; ++r) sacc += pB1[r];
      l_reg += sacc;
      pw0 = (u32x4){PKW(pB0, 0), PKW(pB0, 2), PKW(pB0, 4), PKW(pB0, 6)}; pw1 = (u32x4){PKW(pB0, 8), PKW(pB0, 10), PKW(pB0, 12), PKW(pB0, 14)}; pw2 = (u32x4){PKW(pB1, 0), PKW(pB1, 2), PKW(pB1, 4), PKW(pB1, 6)}; pw3 = (u32x4){PKW(pB1, 8), PKW(pB1, 10), PKW(pB1, 12), PKW(pB1, 14)};
      SBAR(); pv(o, vb0 + sl_cur, PAF(0), PAF(1), PAF(2), PAF(3)); }
#undef PKW
#undef PAF
#undef VFR
#undef PIN
#undef GAPA
#undef GAPB
#undef EX
#undef VRD
#undef KRD
#undef STEP
#undef ENDW
#undef MF32
    FINALIZE(hcur);
    asm volatile("s_waitcnt lgkmcnt(0)\n\ts_barrier" ::: "memory");
#undef FINALIZE
#undef DMA_K
#undef DMA_V
#undef ROT
}
#undef SBAR
#undef WAIT_BAR
}

constexpr size_t MiB = 1u << 20;
constexpr size_t WS_CTL = 0, CTL_ZERO_BYTES = 640 * 1024;
constexpr size_t WS_SFLAG = 64 * 1024, SFLAG_PHASE = 272 * 256, WS_ZERO = 32 * 1024  ;
constexpr size_t WS_EFLAG = 544 * 1024, EFLAG_LAYER = 64 * 22;
constexpr size_t WS_MOD = 1 * MiB;
constexpr size_t WS_ROPE = 1 * MiB + 512 * 1024;
constexpr size_t WS_WQKV = 2 * MiB;
constexpr size_t WS_WO = 9 * MiB;
constexpr size_t WS_WPOOL = 14 * MiB;
constexpr size_t WS_WIN = 15 * MiB;
constexpr size_t WS_WOUT = 20 * MiB;
constexpr size_t WS_WUP = 23 * MiB;
constexpr size_t WS_WDN = 73 * MiB;
constexpr size_t WS_H = 95 * MiB;
constexpr size_t WS_BIG1 = 134 * MiB;
constexpr size_t WS_BIG2 = 230 * MiB;
constexpr size_t WS_PARTX = 302 * MiB;
constexpr size_t WS_BIASW = 303 * MiB;
constexpr size_t BW_QKV = 0, BW_WIN = 2 * 5 * 1536, BW_UP = BW_WIN + 5 * 2048;
constexpr size_t BW_CONVP = BW_UP + 4 * 5 * 5632  , BW_GAINP = BW_CONVP + 4 * 22 * 1024  , BW_END = BW_GAINP + 512;
static_assert(BW_END * 4 <= MiB, "BIASW region");
constexpr size_t WS_XB = 304 * MiB;
constexpr size_t WS_END = 343 * MiB;
constexpr size_t WS_SU = WS_BIG1, WS_SV = WS_BIG1 + 40 * MiB, WS_SPART = WS_BIG1 + 80 * MiB;
constexpr size_t WS_EDGE = WS_BIG2 + 60 * MiB;
constexpr size_t WS_Q = WS_BIG2, WS_K = WS_BIG2 + 40 * MiB, WS_V = WS_K + 10 * MiB;
static_assert((size_t)NTOK * FF * 2 <= 96 * MiB && (size_t)NTOK * RP * 2 <= 40 * MiB && WS_XB + (size_t)NTOK * RP * 2 <= WS_END && WS_H + (size_t)NTOK * RP * 2 <= WS_BIG1 && WS_WUP + (size_t)4 * FF2 * RP * 2 <= WS_WDN, "ws map");

constexpr int RING_BYTES = 131072, LDSCTL_OFF = RING_BYTES, MISC_OFF = LDSCTL_OFF + 320, XB_OFF = LDSCTL_OFF + 1024  ,
              PRM_OFF = XB_OFF + 12288  , PRM_STRIDE = 9728,
              ROPE_OFF = XB_OFF + 2048  , LDS_BYTES = PRM_OFF + 2 * PRM_STRIDE;
static_assert(LDS_BYTES <= 163840, "LDS");

#define XB_TMO      128
#define XB_XCNT(j)  (256  + 64 * (j))
#define XB_XSUB(j)  (1280 + 64 * (j))
#define XB_XGEN(j)  (2304 + 64 * (j))
#define XB_TOP      3328
#define XB_TOPGEN   3392
#define XCD_BAR_WORDS 3456
#define XB_SPIN_CAP (1u << 18)
__device__ __forceinline__ unsigned xb_ld(unsigned* p)              { return __hip_atomic_load(p, __ATOMIC_RELAXED, __HIP_MEMORY_SCOPE_AGENT); }
__device__ __forceinline__ unsigned xb_add(unsigned* p, unsigned v) { return __hip_atomic_fetch_add(p, v, __ATOMIC_RELAXED, __HIP_MEMORY_SCOPE_AGENT); }
__device__ __forceinline__ unsigned xb_xcc_id() { return (unsigned)__builtin_amdgcn_s_getreg((3 << 11) | 20) & 0xFu; }
#define XB_SPIN(cond, bar) do { unsigned _sp = 0; while (cond) { __builtin_amdgcn_s_sleep(1); \
    if ((++_sp & 255u) == 0u) { if (xb_ld(&(bar)[XB_TMO])) break; if (_sp > XB_SPIN_CAP) { atomicAdd(&(bar)[XB_TMO], 1u); break; } } } } while (0)
struct XcdBarrier { unsigned* bar; unsigned x; volatile LAS unsigned* st; };
__device__ __forceinline__ XcdBarrier xcd_barrier_post(unsigned* bar, volatile LAS unsigned* st) {
    XcdBarrier b; b.bar = bar; b.x = xb_xcc_id(); b.st = st;
    if (threadIdx.x == 0) (void)xb_add(&bar[XB_XCNT(b.x)], 1u);
    return b;
}
__device__ __forceinline__ void xcd_barrier_complete(unsigned* bar, unsigned x, unsigned& nloc, unsigned& nx) {
    const unsigned G = gridDim.x * gridDim.y * gridDim.z;
    unsigned sum, cnt, mine, sp = 0u;
    for (;;) {
        sum = 0u; cnt = 0u; mine = 0u;
#pragma unroll
        for (unsigned j = 0; j < 16; ++j) { const unsigned c = xb_ld(&bar[XB_XCNT(j)]); sum += c; cnt += (c > 0u) ? 1u : 0u; mine = (j == x) ? c : mine; }
        if (sum == G) break;
        __builtin_amdgcn_s_sleep(1);
        if ((++sp & 255u) == 0u) { if (xb_ld(&bar[XB_TMO])) break; if (sp > XB_SPIN_CAP) { atomicAdd(&bar[XB_TMO], 1u); break; } }
    }
    nloc = mine > 0u ? mine : 1u; nx = cnt > 0u ? cnt : 1u;
}
__device__ __forceinline__ void xcd_barrier(const XcdBarrier& b) {
    asm volatile("s_waitcnt vmcnt(0)" ::: "memory");
    __syncthreads();
    if (threadIdx.x == 0) {
        unsigned long long bar_u = (unsigned long long)b.bar; unsigned blo = __builtin_amdgcn_readfirstlane((unsigned)bar_u), bhi = __builtin_amdgcn_readfirstlane((unsigned)(bar_u >> 32));
        asm volatile("" : "+s"(blo), "+s"(bhi)); unsigned* bar = (unsigned*)(((unsigned long long)bhi << 32) | blo); unsigned bx = __builtin_amdgcn_readfirstlane(b.x); asm volatile("" : "+s"(bx));
        __builtin_amdgcn_s_waitcnt(0);
        unsigned nloc = b.st[0], nx = b.st[1];
        if (nloc == 0u) { xcd_barrier_complete(bar, bx, nloc, nx); b.st[0] = nloc; b.st[1] = nx; }
        const unsigned old = xb_add(&bar[XB_XSUB(bx)], 1u);
        const unsigned gen = old / nloc;
        if (old + 1u == (gen + 1u) * nloc) {
            __builtin_amdgcn_fence(__ATOMIC_RELEASE, "agent");
            asm volatile("s_waitcnt vmcnt(0)" ::: "memory");
            const unsigned og = xb_add(&bar[XB_TOP], 1u);
            const unsigned tg = og / nx;
            if (og + 1u == (tg + 1u) * nx) xb_add(&bar[XB_TOPGEN], 1u);
            else XB_SPIN(xb_ld(&bar[XB_TOPGEN]) == tg, bar);
            __builtin_amdgcn_fence(__ATOMIC_ACQUIRE, "agent");
            xb_add(&bar[XB_XGEN(bx)], 1u);
            asm volatile("s_waitcnt vmcnt(0)" ::: "memory");
        } else {
            XB_SPIN(xb_ld(&bar[XB_XGEN(bx)]) == gen, bar);
            __builtin_amdgcn_fence(__ATOMIC_ACQUIRE, "agent");
            asm volatile("s_waitcnt vmcnt(0)" ::: "memory");
        }
    }
    __syncthreads();
}

struct Params { const float* in[24]; float* out; unsigned char* ws; };
enum { I_X = 0, I_C, I_CTX, I_CCTX, I_ADAW, I_ADAB, I_NORMW, I_WQKV, I_QG, I_KG, I_WO, I_POOLW, I_POOLB, I_POOLS, I_SWIN, I_SVG, I_SWS, I_SBS, I_SWOUT, I_WUP, I_CONVW, I_CONVB, I_WDN, I_FNORM };

struct Frame {
    unsigned char* ws; float* X;
    LAS unsigned char* lds3;
    float* lds;
};
__device__ __forceinline__ const float* inp(const Params& p, int k) { asm volatile("" : "+s"(k)); return p.in[k]; }
#define IN(k) inp(p, (k))
#define PHASE_IDS int tid = threadIdx.x; asm volatile("" : "+v"(tid)); const int lane = tid & 63, wave = __builtin_amdgcn_readfirstlane(tid >> 6); int bid = blockIdx.x; asm volatile("" : "+s"(bid)); const int G = gridDim.x; (void)lane; (void)wave; (void)bid; (void)G;
__device__ __forceinline__ unsigned char* wsp(unsigned char* ws, unsigned off) { asm volatile("" : "+s"(off)); return ws + off; }
#define WSP(T, off) ((T*)wsp(F.ws, (unsigned)(off)))

__device__ __forceinline__ float wave_sum(float v) {
#pragma unroll
    for (int o = 32; o > 0; o >>= 1) v += __shfl_xor(v, o);
    return v;
}
__device__ __forceinline__ int vidx(int r) { return r < NLAT ? r / L : 4; }
__device__ __forceinline__ float silu_f(float x) { return x / (1.f + expf(-x)); }


__device__ __forceinline__ void dma1k(const void* src, LAS unsigned char* dst, int lane) {
    __builtin_amdgcn_global_load_lds((const unsigned*)((const char*)src + lane * 16), (LAS unsigned*)dst, 16, 0, 0);
}
__device__ __forceinline__ void epi_sync() { asm volatile("s_waitcnt vmcnt(0) lgkmcnt(0)" ::: "memory"); __builtin_amdgcn_s_barrier(); asm volatile("" ::: "memory"); }
__device__ __forceinline__ void row_rs(const LAS float* prm, int rl_base, float (&rs)[2][4]) {
#pragma unroll
    for (int ai = 0; ai < 2; ++ai)
#pragma unroll
        for (int m = 0; m < 4; ++m) { const f32x4 q = *(const LAS f32x4*)(prm + (rl_base + ai * 128 + m * 16) * 4); rs[ai][m] = rsqrtf(((q[0] + q[1]) + (q[2] + q[3])) * (1.f / D) + EPS); }
}
template <bool POOL, bool FINM = false>
struct EpiResid {
    static __host__ __device__ __forceinline__ int brow(int R) { const int rho = R & 31, n = rho >> 4, i = rho & 15; return (R & ~31) + 8 * (i >> 2) + 4 * n + (i & 3); }
    bf16_t* X  ; const float* mod_layer; int part; const float* bias; const float* scale;
    bf16_t* Hn; float* PARTX; const float* nwn; const float* modn; int partn; LAS float* sred  ; LAS float* prm;
    static constexpr int FIN_TAG = 99;
    __device__ __forceinline__ void prefetch(const pg8::Unit& u, int wid, int lane, int pbuf) const {
        const int rt = u.pm * 256, v = rt >= NLAT ? 4 : rt / L; const unsigned c = u.pn * 256; LAS unsigned char* pb = (LAS unsigned char*)prm + pbuf * PRM_STRIDE;
        if (wid == 0) dma1k(mod_layer + ((size_t)v * 6 + part) * D + c, pb, lane);
        if (Hn != nullptr) { if (wid == 1) dma1k(nwn + c, pb + 1024, lane); if (wid == 2) dma1k(modn + ((size_t)v * 6 + partn) * D + c, pb + 2048, lane); }
        if (POOL) { if (wid == 3) dma1k(scale + c, pb + 3072, lane); if (wid == 4) dma1k(bias + c, pb + 4096, lane); }
    }
    __device__ __forceinline__ void operator()(const f32x4 (&acc)[2][2][4][2], const pg8::Unit& u, int wr, int wc, int fr, int fq, int pbuf) const {
        const LAS float* prm = this->prm + pbuf * (PRM_STRIDE / 4);
        const int rt = u.pm * 256; const bool isctx = rt >= NLAT; const int v = isctx ? 4 : rt / L;
        const bf16_t* src = X + (size_t)rt * RP; bf16_t* dst = X + (size_t)rt * RP;
        const int tid = (wr * 4 + wc) * 64 + fq * 16 + fr;
        const bool next = Hn != nullptr, fin = FINM && !next && partn == FIN_TAG, need_ss = next || fin;
        const int colu = wc * 32 + 8 * fq, col0 = u.pn * 256 + colu;
#define RES_LOAD(XV, g_) do { const int c_ = col0 + ((g_) >> 1) * 128; _Pragma("unroll") for (int m = 0; m < 4; ++m) \
            XV[m] = *(const u32x4*)(src + (unsigned)((wr * 64 + fr + ((g_) & 1) * 128 + m * 16) * RP + c_)); } while (0)
        u32x4 xA[4], xB[4];
        RES_LOAD(xA, 0); RES_LOAD(xB, 1);
        float ss[2][4];
#pragma unroll
        for (int ai = 0; ai < 2; ++ai)
#pragma unroll
            for (int m = 0; m < 4; ++m) ss[ai][m] = 0.f;
#define RES_PROC(XV, g_) do { constexpr int bj_ = (g_) >> 1, ai = (g_) & 1; const int cu = colu + bj_ * 128, c = col0 + bj_ * 128; \
            f32x4 gv0 = *(const LAS f32x4*)(prm + cu), gv1 = *(const LAS f32x4*)(prm + cu + 4), ga0, ga1, gn0, gn1; \
            if (POOL) { gv0 = gv0 * *(const LAS f32x4*)(prm + 768 + cu); gv1 = gv1 * *(const LAS f32x4*)(prm + 768 + cu + 4); ga0 = gv0 * *(const LAS f32x4*)(prm + 1024 + cu); ga1 = gv1 * *(const LAS f32x4*)(prm + 1024 + cu + 4); } \
            if (next) { gn0 = *(const LAS f32x4*)(prm + 256 + cu) * (*(const LAS f32x4*)(prm + 512 + cu) + 1.f); gn1 = *(const LAS f32x4*)(prm + 256 + cu + 4) * (*(const LAS f32x4*)(prm + 512 + cu + 4) + 1.f); } \
            _Pragma("unroll") for (int m = 0; m < 4; ++m) { const int rl = wr * 64 + fr + ai * 128 + m * 16; const unsigned off = (unsigned)rl * RP + c; \
                const u32x4 xw_ = XV[m]; const f32x4 xo0 = unpkh4((u32x2){xw_.x, xw_.y}), xo1 = unpkh4((u32x2){xw_.z, xw_.w}); \
                f32x4 xn0 = xo0 + gv0 * acc[ai][bj_][m][0], xn1 = xo1 + gv1 * acc[ai][bj_][m][1]; if (POOL) { xn0 = xn0 + ga0; xn1 = xn1 + ga1; } \
                { u32x4 xw; xw.x = pkh2(xn0[0], xn0[1]); xw.y = pkh2(xn0[2], xn0[3]); xw.z = pkh2(xn1[0], xn1[1]); xw.w = pkh2(xn1[2], xn1[3]); *(u32x4*)(dst + off) = xw; } \
                if (need_ss) ss[ai][m] += ((xn0[0] * xn0[0] + xn0[1] * xn0[1]) + (xn0[2] * xn0[2] + xn0[3] * xn0[3])) + ((xn1[0] * xn1[0] + xn1[1] * xn1[1]) + (xn1[2] * xn1[2] + xn1[3] * xn1[3])); \
                if (next) { const f32x4 hv0 = xn0 * gn0, hv1 = xn1 * gn1; \
                    u32x4 w; w.x = pk2(hv0[0], hv0[1]); w.y = pk2(hv0[2], hv0[3]); w.z = pk2(hv1[0], hv1[1]); w.w = pk2(hv1[2], hv1[3]); *(u32x4*)(Hn + (unsigned)(rt + rl) * RP + c) = w; } } } while (0)
        RES_PROC(xA, 0); asm volatile("" ::: "memory");
        RES_LOAD(xA, 2); asm volatile("" ::: "memory");
        RES_PROC(xB, 1); asm volatile("" ::: "memory");
        RES_LOAD(xB, 3); asm volatile("" ::: "memory");
        RES_PROC(xA, 2); asm volatile("" ::: "memory");
        RES_PROC(xB, 3);
#undef RES_LOAD
#undef RES_PROC
        if (need_ss) {
#pragma unroll
            for (int ai = 0; ai < 2; ++ai)
#pragma unroll
                for (int m = 0; m < 4; ++m) { float t = ss[ai][m]; t += __shfl_xor(t, 16); t += __shfl_xor(t, 32);
                    if (fq == 0) sred[(wr * 64 + fr + ai * 128 + m * 16) * 4 + wc] = t; }
            asm volatile("s_waitcnt lgkmcnt(0)" ::: "memory"); __builtin_amdgcn_s_barrier(); asm volatile("" ::: "memory");
            if (tid < 256) { const f32x4 q = *(const LAS f32x4*)(sred + tid * 4); const float t = (q[0] + q[1]) + (q[2] + q[3]);
                if (!fin) PARTX[(unsigned)(rt + tid) * 4u + u.pn] = t;
                else { const __amdgpu_buffer_rsrc_t prs = __builtin_amdgcn_make_buffer_rsrc((void*)PARTX, 0, 0x7fffffff, 0x00020000);
                       __builtin_amdgcn_raw_buffer_store_b32(__builtin_bit_cast(unsigned, t), prs, ((unsigned)(rt + tid) * 4u + u.pn) * 4u, 0, 16  ); } }
        }
    }
};


template <class Epi> struct EpiTailT {
    static __host__ __device__ __forceinline__ int brow(int R) { return Epi::brow(R); }
    __device__ __forceinline__ void prefetch(const pg8::Unit&, int, int, int) const {}
    float* slab; unsigned* flags;
    __device__ __forceinline__ void operator()(const f32x4 (&acc)[2][2][4][2], const pg8::Unit& u, int wr, int wc, int fr, int fq, int pbuf) const {
        const int tid = (wr * 4 + wc) * 64 + fq * 16 + fr; const unsigned ui = u.rng;
        const __amdgpu_buffer_rsrc_t rsrc = __builtin_amdgcn_make_buffer_rsrc((void*)slab, 0, 0x7fffffff, 0x00020000);
        const unsigned voff = ui * 131072u + (unsigned)tid * 16u;
#pragma unroll
        for (int ai = 0; ai < 2; ++ai)
#pragma unroll
            for (int bj = 0; bj < 2; ++bj)
#pragma unroll
                for (int m = 0; m < 4; ++m) { const f32x4 a = acc[ai][bj][m][0], b = acc[ai][bj][m][1];
                    u32x4 w; w.x = pkh2(a[0], a[1]); w.y = pkh2(a[2], a[3]); w.z = pkh2(b[0], b[1]); w.w = pkh2(b[2], b[3]);
                    __builtin_amdgcn_raw_buffer_store_b128(w, rsrc, voff, ((ai * 2 + bj) * 4 + m) * 8192, 16  ); }
        asm volatile("s_waitcnt vmcnt(0)" ::: "memory"); __builtin_amdgcn_s_barrier(); asm volatile("" ::: "memory");
        if (tid == 0) __hip_atomic_store(flags + ui * 64, 1u, __ATOMIC_RELAXED, __HIP_MEMORY_SCOPE_AGENT);
    }
};
template <class Epi> struct EpiHead {
    static __host__ __device__ __forceinline__ int brow(int R) { return Epi::brow(R); }
    __device__ __forceinline__ void prefetch(const pg8::Unit& u, int wid, int lane, int pbuf) const { E.prefetch(u, wid, lane, pbuf); }
    Epi E; const float* slab; unsigned* flags; LAS unsigned char* lds3  ;
    __device__ __forceinline__ void operator()(f32x4 (&acc)[2][2][4][2], const pg8::Unit& u, int wr, int wc, int fr, int fq, int pbuf) const {
        const int tid = (wr * 4 + wc) * 64 + fq * 16 + fr; const unsigned ui = u.rng + 1;
        const bool head = u.role == 2;
        if (head) {
            if (tid == 0) { unsigned sp = 0;
                while (__hip_atomic_load(flags + ui * 64, __ATOMIC_RELAXED, __HIP_MEMORY_SCOPE_AGENT) == 0u) { __builtin_amdgcn_s_sleep(2); if (++sp > (1u << 22)) break; }
                __builtin_amdgcn_fence(__ATOMIC_ACQUIRE, "agent"); asm volatile("s_waitcnt vmcnt(0)" ::: "memory"); }
            asm volatile("s_waitcnt vmcnt(0) lgkmcnt(0)" ::: "memory"); __builtin_amdgcn_s_barrier(); asm volatile("" ::: "memory");
            const int w8 = wr * 4 + wc; const char* sp = (const char*)slab + (size_t)ui * 131072u + w8 * 1024;
#pragma unroll
            for (int g = 0; g < 16; ++g) dma1k(sp + g * 8192, lds3 + g * 8192 + w8 * 1024, (fq << 4) | fr);
            asm volatile("s_waitcnt vmcnt(0)" ::: "memory");
        }
        const unsigned lbase = head ? (unsigned)tid * 16u : (unsigned)XB_OFF; const int gmul = head ? 8192 : 0;
#pragma unroll
        for (int ai = 0; ai < 2; ++ai)
#pragma unroll
            for (int bj = 0; bj < 2; ++bj)
#pragma unroll
                for (int m = 0; m < 4; ++m) { const u32x4 t = *(const LAS u32x4*)(lds3 + lbase + ((ai * 2 + bj) * 4 + m) * gmul);
                    u32x2 lo, hi; lo.x = t.x; lo.y = t.y; hi.x = t.z; hi.y = t.w;
                    acc[ai][bj][m][0] = acc[ai][bj][m][0] + unpkh4(lo); acc[ai][bj][m][1] = acc[ai][bj][m][1] + unpkh4(hi);
                    asm volatile("" : "+v"(acc[ai][bj][m][0]), "+v"(acc[ai][bj][m][1]) :: "memory"); }
        asm volatile("s_waitcnt lgkmcnt(0)" ::: "memory");
        E(acc, u, wr, wc, fr, fq, pbuf);
    }
};

struct EpiQKV {
    static __host__ __device__ __forceinline__ int brow(int R) { const int wc = R >> 5, n = (R >> 4) & 1, i = R & 15, fq = i >> 2, reg = i & 3; return 64 * wc + 32 * (fq >> 1) + 8 * (fq & 1) + 4 * n + reg; }
    bf16_t* Q; bf16_t* K; size_t kv_stride  ; const float* gainp  ; const float* PARTX; const float* bw  ; LAS float* prm; const LAS float* rope;
    __device__ __forceinline__ void prefetch(const pg8::Unit& u, int wid, int lane, int pbuf) const {
        const int rt = u.pm * 256; LAS unsigned char* pb = (LAS unsigned char*)prm + pbuf * PRM_STRIDE;
        if (wid < 4) dma1k(PARTX + (size_t)rt * 4 + wid * 256, pb + wid * 1024, lane);
        if (wid == 4) dma1k(bw + (size_t)(rt >= NLAT ? 4 : rt / L) * QKVW + u.pn * 256, pb + 4096, lane);
        if (wid == 5) dma1k(gainp, pb + 5120, lane);
    }
    __device__ __forceinline__ void operator()(f32x4 (&acc)[2][2][4][2], const pg8::Unit& u, int wr, int wc, int fr, int fq, int pbuf) const {
        const LAS float* prm = this->prm + pbuf * (PRM_STRIDE / 4);
        const int rt = u.pm * 256; const bool isctx = rt >= NLAT; const int type = u.pn < 4 ? 0 : u.pn - 3;
        const int dimbase = 32 * (fq >> 1) + 8 * (fq & 1);
        const int tid = (wr * 4 + wc) * 64 + fq * 16 + fr;
        { float rsx[2][4]; row_rs(prm, wr * 64 + fr, rsx);
#pragma unroll
          for (int bj = 0; bj < 2; ++bj)
#pragma unroll
              for (int n = 0; n < 2; ++n) { const f32x4 bwv = *(const LAS f32x4*)(prm + 1024 + wc * 64 + dimbase + 16 * bj + 4 * n);
#pragma unroll
                  for (int ai = 0; ai < 2; ++ai)
#pragma unroll
                      for (int m = 0; m < 4; ++m) acc[ai][bj][m][n] = acc[ai][bj][m][n] * rsx[ai][m] + bwv; } }
        const LAS float* gp = prm + (type == 0 ? 1280 : 1344) + dimbase;
        const float osc = type == 0 ? attn_body::C2 : 1.f;
#pragma unroll
        for (int ai = 0; ai < 2; ++ai)
#pragma unroll
            for (int m = 0; m < 4; ++m) {
                const int r = rt + wr * 64 + fr + ai * 128 + m * 16;
                f32x4 y[2][2];
#pragma unroll
                for (int bj = 0; bj < 2; ++bj)
#pragma unroll
                    for (int n = 0; n < 2; ++n) y[bj][n] = acc[ai][bj][m][n];
                if (type < 2) {
                    float ss = 0.f;
#pragma unroll
                    for (int bj = 0; bj < 2; ++bj)
#pragma unroll
                        for (int n = 0; n < 2; ++n) { const f32x4 a = y[bj][n]; ss += (a[0] * a[0] + a[1] * a[1]) + (a[2] * a[2] + a[3] * a[3]); }
                    ss += __shfl_xor(ss, 16); ss += __shfl_xor(ss, 32);
                    const float rs = rsqrtf(ss * (1.f / HD) + EPS) * osc;
#pragma unroll
                    for (int bj = 0; bj < 2; ++bj)
#pragma unroll
                        for (int n = 0; n < 2; ++n) y[bj][n] = y[bj][n] * rs * *(const LAS f32x4*)(gp + 16 * bj + 4 * n);
                    if (!isctx) {
                        const int t = r & (L - 1); const int pos = (fq >> 1) ? (t & 63) : (t >> 6);
#pragma unroll
                        for (int n = 0; n < 2; ++n) {
                            const f32x4 cs = *(const LAS f32x4*)(rope + pos * 16 + 8 * (fq & 1) + 4 * n), sn = *(const LAS f32x4*)(rope + 1024 + pos * 16 + 8 * (fq & 1) + 4 * n);
                            const f32x4 a = y[0][n], b = y[1][n];
                            y[0][n] = a * cs - b * sn; y[1][n] = b * cs + a * sn;
                        }
                    }
                }
                bf16_t* dst;
                if (type == 0) dst = Q + (unsigned)(r * RP + (4 * u.pn + wc) * 64);
                else { const int kvrow = isctx ? ((r - NLAT) >> 8) * (LC + L) + ((r - NLAT) & (LC - 1)) : (r >> 12) * (LC + L) + LC + (r & (L - 1));
                       dst = K + (size_t)(type - 1) * kv_stride + (unsigned)(kvrow * 256 + wc * 64); }
                u32x4 w0, w1;
                w0.x = pk2(y[0][0][0], y[0][0][1]); w0.y = pk2(y[0][0][2], y[0][0][3]); w0.z = pk2(y[0][1][0], y[0][1][1]); w0.w = pk2(y[0][1][2], y[0][1][3]);
                w1.x = pk2(y[1][0][0], y[1][0][1]); w1.y = pk2(y[1][0][2], y[1][0][3]); w1.z = pk2(y[1][1][0], y[1][1][1]); w1.w = pk2(y[1][1][2], y[1][1][3]);
#pragma unroll
                for (int e = 0; e < 4; ++e) { auto sw = __builtin_amdgcn_permlane32_swap(w0[e], w1[e], false, false); w0[e] = sw[0]; w1[e] = sw[1]; }
                *(u32x4*)(dst + 8 * fq) = w0; *(u32x4*)(dst + 32 + 8 * fq) = w1;
            }
    }
};

template <int CTRL> __device__ __forceinline__ float dppf(float oldv, float src) { return __builtin_bit_cast(float, __builtin_amdgcn_update_dpp(__builtin_bit_cast(int, oldv), __builtin_bit_cast(int, src), CTRL, 0xf, 0xf, false)); }
template <int CTRL> __device__ __forceinline__ float dppz(float src) { return __builtin_bit_cast(float, __builtin_amdgcn_update_dpp(0, __builtin_bit_cast(int, src), CTRL, 0xf, 0xf, true)); }
template <int CTRL> __device__ __forceinline__ f32x4 dpp4(f32x4 oldv, f32x4 src) { f32x4 r; r[0] = dppf<CTRL>(oldv[0], src[0]); r[1] = dppf<CTRL>(oldv[1], src[1]); r[2] = dppf<CTRL>(oldv[2], src[2]); r[3] = dppf<CTRL>(oldv[3], src[3]); return r; }
__device__ __forceinline__ float silu_fast(float g) { return g * __builtin_amdgcn_rcpf(1.f + __builtin_amdgcn_exp2f(-1.4426950408889634f * g)); }
__device__ __forceinline__ void conv_in(f32x4& r, const f32x4& x, const f32x4& w0, const f32x4& w2) {
    float r0 = r[0], r1 = r[1], r2 = r[2], r3 = r[3];
    asm volatile("s_nop 1\n\t"
                 "v_fmac_f32_dpp %0, %4, %8 row_shr:1 row_mask:0xf bank_mask:0xf bound_ctrl:0\n\t"
                 "v_fmac_f32_dpp %1, %5, %9 row_shr:1 row_mask:0xf bank_mask:0xf bound_ctrl:0\n\t"
                 "v_fmac_f32_dpp %2, %6, %10 row_shr:1 row_mask:0xf bank_mask:0xf bound_ctrl:0\n\t"
                 "v_fmac_f32_dpp %3, %7, %11 row_shr:1 row_mask:0xf bank_mask:0xf bound_ctrl:0\n\t"
                 "v_fmac_f32_dpp %0, %4, %12 row_shl:1 row_mask:0xf bank_mask:0xf bound_ctrl:0\n\t"
                 "v_fmac_f32_dpp %1, %5, %13 row_shl:1 row_mask:0xf bank_mask:0xf bound_ctrl:0\n\t"
                 "v_fmac_f32_dpp %2, %6, %14 row_shl:1 row_mask:0xf bank_mask:0xf bound_ctrl:0\n\t"
                 "v_fmac_f32_dpp %3, %7, %15 row_shl:1 row_mask:0xf bank_mask:0xf bound_ctrl:0"
                 : "+v"(r0), "+v"(r1), "+v"(r2), "+v"(r3)
                 : "v"(x[0]), "v"(x[1]), "v"(x[2]), "v"(x[3]), "v"(w0[0]), "v"(w0[1]), "v"(w0[2]), "v"(w0[3]), "v"(w2[0]), "v"(w2[1]), "v"(w2[2]), "v"(w2[3]));
    r = (f32x4){r0, r1, r2, r3};
}
template <bool PREV> __device__ __forceinline__ void conv_edge(f32x4& r, const f32x4& x, const f32x4& we) {
    float r0 = r[0], r1 = r[1], r2 = r[2], r3 = r[3];
    if (PREV) asm volatile("s_nop 1\n\t"
                 "v_fmac_f32_dpp %0, %4, %8 row_ror:1 row_mask:0xf bank_mask:0xf\n\t"
                 "v_fmac_f32_dpp %1, %5, %9 row_ror:1 row_mask:0xf bank_mask:0xf\n\t"
                 "v_fmac_f32_dpp %2, %6, %10 row_ror:1 row_mask:0xf bank_mask:0xf\n\t"
                 "v_fmac_f32_dpp %3, %7, %11 row_ror:1 row_mask:0xf bank_mask:0xf"
                 : "+v"(r0), "+v"(r1), "+v"(r2), "+v"(r3) : "v"(x[0]), "v"(x[1]), "v"(x[2]), "v"(x[3]), "v"(we[0]), "v"(we[1]), "v"(we[2]), "v"(we[3]));
    else asm volatile("s_nop 1\n\t"
                 "v_fmac_f32_dpp %0, %4, %8 row_ror:15 row_mask:0xf bank_mask:0xf\n\t"
                 "v_fmac_f32_dpp %1, %5, %9 row_ror:15 row_mask:0xf bank_mask:0xf\n\t"
                 "v_fmac_f32_dpp %2, %6, %10 row_ror:15 row_mask:0xf bank_mask:0xf\n\t"
                 "v_fmac_f32_dpp %3, %7, %11 row_ror:15 row_mask:0xf bank_mask:0xf"
                 : "+v"(r0), "+v"(r1), "+v"(r2), "+v"(r3) : "v"(x[0]), "v"(x[1]), "v"(x[2]), "v"(x[3]), "v"(we[0]), "v"(we[1]), "v"(we[2]), "v"(we[3]));
    r = (f32x4){r0, r1, r2, r3};
}
struct EpiUpConv {
    static __host__ __device__ __forceinline__ int brow(int R) { const int rho = R & 31, n = rho >> 4, i = rho & 15; return (R & ~31) + 8 * (i >> 2) + 4 * n + (i & 3); }
    bf16_t* G; float* EDGE; const float* convp  ; LAS float* xb; const float* PARTX; const float* bwp  ; LAS float* prm; unsigned* eflag  ;
    __device__ __forceinline__ void prefetch(const pg8::Unit& u, int wid, int lane, int pbuf) const {
        const int rt = u.pm * 256; LAS unsigned char* pb = (LAS unsigned char*)prm + pbuf * PRM_STRIDE;
        if (wid < 4) { dma1k(PARTX + (size_t)rt * 4 + wid * 256, pb + wid * 1024, lane); dma1k(convp + (size_t)u.pn * 1024 + wid * 256, pb + 5120 + wid * 1024, lane); }
        if (wid == 4) dma1k(bwp + ((size_t)(rt >= NLAT ? 4 : rt / L) * 22 + u.pn) * 256, pb + 4096, lane);
    }
    __device__ __forceinline__ void operator()(f32x4 (&acc)[2][2][4][2], const pg8::Unit& u, int wr, int wc, int fr, int fq, int pbuf) const {
        const LAS float* prm = this->prm + pbuf * (PRM_STRIDE / 4);
        constexpr int DPP_SHR1 = 0x111, DPP_SHL1 = 0x101, DPP_ROR1 = 0x121, DPP_ROL1 = 0x12F;
        const int colw = 32 * wc + 8 * fq, f0 = 128 * u.pn, rt = u.pm * 256;
        const int tid = (wr * 4 + wc) * 64 + fq * 16 + fr;
        const bool halo_below = u.pm < NLAT / 256 && (u.pm & 15) != 15;
        { float rsx[2][4]; row_rs(prm, wr * 64 + fr, rsx);
#pragma unroll
          for (int bj = 0; bj < 2; ++bj)
#pragma unroll
              for (int n = 0; n < 2; ++n) { const f32x4 bwv = *(const LAS f32x4*)(prm + 1024 + bj * 128 + colw + 4 * n);
#pragma unroll
                  for (int ai = 0; ai < 2; ++ai)
#pragma unroll
                      for (int m = 0; m < 4; ++m) acc[ai][bj][m][n] = acc[ai][bj][m][n] * rsx[ai][m] + bwv; } }
#pragma unroll
        for (int ai = 0; ai < 2; ++ai) { const int q = 2 * ai + wr;
#pragma unroll
            for (int bj = 0; bj < 2; ++bj)
#pragma unroll
                for (int n = 0; n < 2; ++n) {
                    if (fr == 0) *(LAS f32x4*)(xb + (((q + 1) * 2 + 0) * 2 + bj) * 128 + colw + 4 * n) = acc[ai][bj][0][n];
                    if (fr == 15) *(LAS f32x4*)(xb + (((q + 1) * 2 + 1) * 2 + bj) * 128 + colw + 4 * n) = acc[ai][bj][3][n];
                } }
        if (wr == 0 && fr < 2) {
#pragma unroll
            for (int bj = 0; bj < 2; ++bj)
#pragma unroll
                for (int n = 0; n < 2; ++n) *(f32x4*)(EDGE + (unsigned)((u.pm * 4 + fr) * FF2 + bj * FF + f0 + colw + 4 * n)) = acc[0][bj][0][n]; }
        if (wr == 1 && fr >= 14) {
#pragma unroll
            for (int bj = 0; bj < 2; ++bj)
#pragma unroll
                for (int n = 0; n < 2; ++n) __builtin_amdgcn_raw_buffer_store_b128(__builtin_bit_cast(u32x4, acc[1][bj][3][n]), __builtin_amdgcn_make_buffer_rsrc((void*)EDGE, 0, 0x7fffffff, 0x00020000),
                                                                                    (unsigned)((u.pm * 4 + (fr - 12)) * FF2 + bj * FF + f0 + colw + 4 * n) * 4u, 0, 16  ); }
        asm volatile("s_waitcnt lgkmcnt(0)" ::: "memory"); __builtin_amdgcn_s_barrier(); asm volatile("" ::: "memory");
        if (tid == 0) { LAS unsigned* pend = (LAS unsigned*)((LAS unsigned char*)xb - XB_OFF + MISC_OFF + 64); const unsigned pi = *pend;
            if (pi) __hip_atomic_store(eflag + (pi - 1u), 1u, __ATOMIC_RELAXED, __HIP_MEMORY_SCOPE_AGENT);
            *pend = halo_below ? (unsigned)(u.pm * 22 + u.pn + 1) : 0u; }
        const float m0 = fr == 0 ? 1.f : 0.f, m15 = fr == 15 ? 1.f : 0.f;
#pragma unroll
        for (int bj = 0; bj < 2; ++bj)
#pragma unroll
            for (int n = 0; n < 2; ++n) {
                const LAS float* pp = prm + 1024 + bj * 128 + colw + 4 * n;
                const f32x4 w0 = *(const LAS f32x4*)(pp + 256), w1 = *(const LAS f32x4*)(pp + 512), w2 = *(const LAS f32x4*)(pp + 768), bb = *(const LAS f32x4*)(pp + 1024);
                const f32x4 w0e = w0 * m0, w2e = w2 * m15;
#pragma unroll
                for (int ai = 0; ai < 2; ++ai) { const int q = 2 * ai + wr;
                    const f32x4 lo = *(const LAS f32x4*)(xb + ((q * 2 + 1) * 2 + bj) * 128 + colw + 4 * n);
                    const f32x4 hi = *(const LAS f32x4*)(xb + (((q + 2) * 2 + 0) * 2 + bj) * 128 + colw + 4 * n);
                    f32x4 saved = lo;
#pragma unroll
                    for (int m = 0; m < 4; ++m) {
                        const f32x4 cur = acc[ai][bj][m][n];
                        f32x4 r = w1 * cur + bb;
                        if (m == 0) r = r + lo * w0e; else conv_edge<true>(r, saved, w0e);
                        if (m == 3) r = r + hi * w2e; else conv_edge<false>(r, acc[ai][bj][m + 1][n], w2e);
                        conv_in(r, cur, w0, w2);
                        acc[ai][bj][m][n] = r;
                        saved = cur;
                    } }
            }
#pragma unroll
        for (int ai = 0; ai < 2; ++ai)
#pragma unroll
            for (int m = 0; m < 4; ++m) {
                const int r = rt + ai * 128 + wr * 64 + m * 16 + fr;
                float o[8];
#pragma unroll
                for (int n = 0; n < 2; ++n)
#pragma unroll
                    for (int e = 0; e < 4; ++e) { const float gp = acc[ai][1][m][n][e]; o[4 * n + e] = (gp * acc[ai][0][m][n][e]) * __builtin_amdgcn_rcpf(1.f + __builtin_amdgcn_exp2f(gp)); }
                u32x4 w; w.x = pk2(o[0], o[1]); w.y = pk2(o[2], o[3]); w.z = pk2(o[4], o[5]); w.w = pk2(o[6], o[7]);
                if (ai == 1 && m == 3) { if (!(halo_below && wr == 1 && fr == 15)) *(u32x4*)(G + (unsigned)(r * FF + f0 + colw)) = w; }
                else *(u32x4*)(G + (unsigned)(r * FF + f0 + colw)) = w;
            }
    }
};
__device__ __forceinline__ void up_edge_fix(const pg8::StaticOrder& S, const float* cw, const float* cb, const float* EDGE, bf16_t* Gout, unsigned* eflag, LAS unsigned* pend) {
    int t = threadIdx.x; asm volatile("" : "+v"(t)); const int lane = t & 63, wave = __builtin_amdgcn_readfirstlane(t >> 6);
    if (t == 0) { const unsigned pi = *pend; if (pi) { __hip_atomic_store(eflag + (pi - 1u), 1u, __ATOMIC_RELAXED, __HIP_MEMORY_SCOPE_AGENT); *pend = 0u; } }
    pg8::Unit u;
    for (int i = wave; S.next(i, u); i += NWAVES) {
        if (u.pm >= NLAT / 256 || (u.pm & 15) == 0) continue;
        const int pmA = u.pm - 1, pmB = u.pm;
        { unsigned sp = 0; while (__hip_atomic_load(eflag + pmA * 22 + u.pn, __ATOMIC_RELAXED, __HIP_MEMORY_SCOPE_AGENT) == 0u) { __builtin_amdgcn_s_sleep(2); if (++sp > (1u << 22)) break; } }
        const __amdgpu_buffer_rsrc_t ers = __builtin_amdgcn_make_buffer_rsrc((void*)EDGE, 0, 0x7fffffff, 0x00020000);
        const int which = lane >> 5, f = u.pn * 128 + (lane & 31) * 4;
        const unsigned um = (unsigned)((which == 0 ? pmA * 4 + 2 : pmA * 4 + 3) * FF2) * 4u;
        const unsigned uc = (unsigned)((which == 0 ? pmA * 4 + 3 : pmB * 4 + 0) * FF2) * 4u;
        const unsigned up = (unsigned)((which == 0 ? pmB * 4 + 0 : pmB * 4 + 1) * FF2) * 4u;
        const int r = pmB * 256 - 1 + which;
        f32x4 a[2];
#pragma unroll
        for (int part = 0; part < 2; ++part) { const int col = part * FF + f;
            const f32x4 xm = __builtin_bit_cast(f32x4, __builtin_amdgcn_raw_buffer_load_b128(ers, um + (unsigned)col * 4u, 0, 16)), xc = __builtin_bit_cast(f32x4, __builtin_amdgcn_raw_buffer_load_b128(ers, uc + (unsigned)col * 4u, 0, 16)),
                        xp = __builtin_bit_cast(f32x4, __builtin_amdgcn_raw_buffer_load_b128(ers, up + (unsigned)col * 4u, 0, 16));
            a[part] = *(const f32x4*)(cw + col) * xm + *(const f32x4*)(cw + FF2 + col) * xc + *(const f32x4*)(cw + 2 * FF2 + col) * xp + *(const f32x4*)(cb + col); }
        u32x2 w; w.x = pk2(silu_fast(a[1][0]) * a[0][0], silu_fast(a[1][1]) * a[0][1]); w.y = pk2(silu_fast(a[1][2]) * a[0][2], silu_fast(a[1][3]) * a[0][3]);
        *(u32x2*)(Gout + (size_t)r * FF + f) = w;
    }
}


__device__ __forceinline__ float gelu_fast(float x) { const float u = x * __builtin_fmaf(x * x, -2.885390081777927f * 0.7978845608028654f * 0.044715f, -2.885390081777927f * 0.7978845608028654f); return x * __builtin_amdgcn_rcpf(1.f + __builtin_amdgcn_exp2f(u)); }
struct EpiGelu {
    static __host__ __device__ __forceinline__ int brow(int R) { const int rho = R & 31, n = rho >> 4, i = rho & 15; return (R & ~31) + 8 * (i >> 2) + 4 * n + (i & 3); }
    bf16_t* U; bf16_t* V; float* PART; const float* PARTX; const float* bw  ; LAS float* prm;
    __device__ __forceinline__ void prefetch(const pg8::Unit& u, int wid, int lane, int pbuf) const {
        const int rt = u.pm * 256; LAS unsigned char* pb = (LAS unsigned char*)prm + pbuf * PRM_STRIDE;
        if (wid < 4) dma1k(PARTX + (size_t)rt * 4 + wid * 256, pb + wid * 1024, lane);
        if (wid == 4) dma1k(bw + (size_t)(rt >= NLAT ? 4 : rt / L) * 2048 + u.pn * 256, pb + 4096, lane);
    }
    __device__ __forceinline__ void operator()(f32x4 (&acc)[2][2][4][2], const pg8::Unit& u, int wr, int wc, int fr, int fq, int pbuf) const {
        const LAS float* prm = this->prm + pbuf * (PRM_STRIDE / 4);
        const bool isv = u.pn >= 4; bf16_t* dstb = isv ? V : U; const int colt = (u.pn & 3) * 256 + wc * 32 + 8 * fq;
        const int rt = u.pm * 256, tid = (wr * 4 + wc) * 64 + fq * 16 + fr;
        { float rsx[2][4]; row_rs(prm, wr * 64 + fr, rsx);
#pragma unroll
          for (int bj = 0; bj < 2; ++bj)
#pragma unroll
              for (int n = 0; n < 2; ++n) { const f32x4 bwv = *(const LAS f32x4*)(prm + 1024 + 128 * bj + wc * 32 + 8 * fq + 4 * n);
#pragma unroll
                  for (int ai = 0; ai < 2; ++ai)
#pragma unroll
                      for (int m = 0; m < 4; ++m) acc[ai][bj][m][n] = acc[ai][bj][m][n] * rsx[ai][m] + bwv; } }
#pragma unroll
        for (int ai = 0; ai < 2; ++ai)
#pragma unroll
            for (int m = 0; m < 4; ++m) { const int r = rt + wr * 64 + fr + ai * 128 + m * 16; float ss = 0.f;
#pragma unroll
                for (int bj = 0; bj < 2; ++bj) { float z[8];
#pragma unroll
                    for (int n = 0; n < 2; ++n)
#pragma unroll
                        for (int e = 0; e < 4; ++e) { z[4 * n + e] = gelu_fast(acc[ai][bj][m][n][e]); ss += z[4 * n + e] * z[4 * n + e]; }
                    u32x4 w; w.x = pk2(z[0], z[1]); w.y = pk2(z[2], z[3]); w.z = pk2(z[4], z[5]); w.w = pk2(z[6], z[7]);
                    *(u32x4*)(dstb + (unsigned)(r * RP + colt + bj * 128)) = w; }
                if (isv) { ss += __shfl_xor(ss, 16); ss += __shfl_xor(ss, 32); if (fq == 0) PART[(unsigned)(r * 16 + (u.pn - 4) * 4 + wc)] = ss; }
            }
    }
};
__device__ __forceinline__ void sgu_spatial(const Frame& F, const float* w_s, const float* b_s, const float* vg, const bf16_t* U, const bf16_t* V, const float* PART, bf16_t* Og, int nrows) {
    PHASE_IDS
    typedef short v4i16_t __attribute__((ext_vector_type(4)));
    LAS unsigned char* Vs = F.lds3; LAS float* rsv = (LAS float*)(F.lds3 + 128 * 288);
    const int fr = lane & 15, fq = lane >> 4;
    const int nitems = (nrows / 128) * 8;
    const int m = 16 * wave + fr;
    u32x4 vt[4]; f32x4 pq[4]; f32x4 wa[4][2]; u32x4 uwn[4]; f32x4 gvn[8]; float bsn = 0.f;
#define SGU_LOAD(it_) do { const int ch_ = (it_) >> 3, g_ = (it_) & 7, row0_ = ch_ * 128; \
        _Pragma("unroll") for (int i = 0; i < 4; ++i) { const int e = tid + i * 512, n = e >> 4, c16 = e & 15; vt[i] = *(const u32x4*)(V + (size_t)(row0_ + n) * RP + g_ * 128 + c16 * 8); } \
        if (tid < 128) { _Pragma("unroll") for (int i = 0; i < 4; ++i) pq[i] = *(const f32x4*)(PART + (size_t)(row0_ + tid) * 16 + i * 4); } \
        _Pragma("unroll") for (int ks = 0; ks < 4; ++ks) { const float* wp = w_s + ((size_t)g_ * 128 + m) * 128 + 32 * ks + 8 * fq; wa[ks][0] = *(const f32x4*)wp; wa[ks][1] = *(const f32x4*)(wp + 4); } \
        _Pragma("unroll") for (int cb = 0; cb < 4; ++cb) { const int col = g_ * 128 + 32 * cb + 8 * fq; uwn[cb] = *(const u32x4*)(U + (size_t)(row0_ + m) * RP + col); gvn[2 * cb] = *(const f32x4*)(vg + col); gvn[2 * cb + 1] = *(const f32x4*)(vg + col + 4); } \
        bsn = b_s[g_ * 128 + m]; } while (0)
    if (bid < nitems) SGU_LOAD(bid);
    for (int item = bid; item < nitems; item += G) {
        const int ch = item >> 3, g = item & 7, row0 = ch * 128;
        __syncthreads();
#pragma unroll
        for (int i = 0; i < 4; ++i) { const int e = tid + i * 512, n = e >> 4, c16 = e & 15; *(LAS u32x4*)(Vs + n * 288 + c16 * 16) = vt[i]; }
        if (tid < 128) { float sq = 0.f;
#pragma unroll
            for (int i = 0; i < 4; ++i) sq += (pq[i][0] + pq[i][1]) + (pq[i][2] + pq[i][3]);
            rsv[tid] = rsqrtf(sq * (1.f / D) + EPS); }
        __syncthreads();
        bf16x8 af[4];
#pragma unroll
        for (int ks = 0; ks < 4; ++ks) { const int k0 = 32 * ks + 8 * fq; const f32x4 a0 = wa[ks][0], a1 = wa[ks][1]; const f32x4 r0 = *(const LAS f32x4*)(rsv + k0), r1 = *(const LAS f32x4*)(rsv + k0 + 4);
            u32x4 w; w.x = pk2(a0[0] * r0[0], a0[1] * r0[1]); w.y = pk2(a0[2] * r0[2], a0[3] * r0[3]); w.z = pk2(a1[0] * r1[0], a1[1] * r1[1]); w.w = pk2(a1[2] * r1[2], a1[3] * r1[3]);
            af[ks] = __builtin_bit_cast(bf16x8, w); }
        u32x4 uw[4]; f32x4 gvv[8]; const float bsv = bsn;
#pragma unroll
        for (int cb = 0; cb < 4; ++cb) { uw[cb] = uwn[cb]; gvv[2 * cb] = gvn[2 * cb]; gvv[2 * cb + 1] = gvn[2 * cb + 1]; }
        asm volatile("" ::: "memory");
        if (item + G < nitems) SGU_LOAD(item + G);
        const int q = fr >> 2, pq2 = fr & 3;
#pragma unroll
        for (int cb = 0; cb < 4; ++cb) {
            f32x4 acc0 = {0.f, 0.f, 0.f, 0.f}, acc1 = {0.f, 0.f, 0.f, 0.f};
#pragma unroll
            for (int ks = 0; ks < 4; ++ks) {
                LAS unsigned char* ap = Vs + (32 * ks + 8 * fq + q) * 288 + (32 * cb + 8 * pq2) * 2;
                const v4i16_t lo = __builtin_amdgcn_ds_read_tr16_b64_v4i16((LAS v4i16_t*)ap), hi = __builtin_amdgcn_ds_read_tr16_b64_v4i16((LAS v4i16_t*)(ap + 4 * 288));
                const v4i16_t lo1 = __builtin_amdgcn_ds_read_tr16_b64_v4i16((LAS v4i16_t*)(ap + 8)), hi1 = __builtin_amdgcn_ds_read_tr16_b64_v4i16((LAS v4i16_t*)(ap + 8 + 4 * 288));
                const bf16x8 vf = {lo[0], lo[1], lo[2], lo[3], hi[0], hi[1], hi[2], hi[3]}, vf1 = {lo1[0], lo1[1], lo1[2], lo1[3], hi1[0], hi1[1], hi1[2], hi1[3]};
                acc0 = __builtin_amdgcn_mfma_f32_16x16x32_bf16(vf, af[ks], acc0, 0, 0, 0);
                acc1 = __builtin_amdgcn_mfma_f32_16x16x32_bf16(vf1, af[ks], acc1, 0, 0, 0);
            }
            const int col = g * 128 + 32 * cb + 8 * fq; const size_t off = (size_t)(row0 + m) * RP + col;
            const f32x4 gv0 = gvv[2 * cb], gv1 = gvv[2 * cb + 1]; const u32x4 uwv = uw[cb];
#define BFLO(x) __builtin_bit_cast(float, (x) << 16)
#define BFHI(x) __builtin_bit_cast(float, (x) & 0xffff0000u)
            u32x4 w;
            w.x = pk2(BFLO(uwv.x) * (acc0[0] * gv0[0] + bsv), BFHI(uwv.x) * (acc0[1] * gv0[1] + bsv)); w.y = pk2(BFLO(uwv.y) * (acc0[2] * gv0[2] + bsv), BFHI(uwv.y) * (acc0[3] * gv0[3] + bsv));
            w.z = pk2(BFLO(uwv.z) * (acc1[0] * gv1[0] + bsv), BFHI(uwv.z) * (acc1[1] * gv1[1] + bsv)); w.w = pk2(BFLO(uwv.w) * (acc1[2] * gv1[2] + bsv), BFHI(uwv.w) * (acc1[3] * gv1[3] + bsv));
#undef BFLO
#undef BFHI
            *(u32x4*)(Og + off) = w;
        }
    }
#undef SGU_LOAD
    __syncthreads();
}

__device__ __forceinline__ void p0_transpose_item(const float* W, int K, int N, bf16_t* WT, int ldw, int row_off, float* scr, int item, int lane) {
    const int nblk = N / 32, kb = item / nblk, nb = item % nblk, k0 = 64 * kb, n0 = 32 * nb;
    float wv[32];
#pragma unroll
    for (int i = 0; i < 32; ++i) wv[i] = __builtin_nontemporal_load(&W[(size_t)(k0 + 2 * i + (lane >> 5)) * N + n0 + (lane & 31)]);
#pragma unroll
    for (int i = 0; i < 32; ++i) scr[(2 * i + (lane >> 5)) * 33 + (lane & 31)] = wv[i];
    asm volatile("s_waitcnt lgkmcnt(0)" ::: "memory");
    const int c = lane & 7;
#pragma unroll
    for (int j = 0; j < 4; ++j) { const int n = (lane >> 3) + 8 * j; const float* s = scr + (8 * c) * 33 + n;
        u32x4 o; o.x = pk2(s[0 * 33], s[1 * 33]); o.y = pk2(s[2 * 33], s[3 * 33]); o.z = pk2(s[4 * 33], s[5 * 33]); o.w = pk2(s[6 * 33], s[7 * 33]);
        *(u32x4*)(WT + (size_t)(row_off + n0 + n) * ldw + k0 + 8 * c) = o; }
    asm volatile("s_waitcnt lgkmcnt(0)" ::: "memory");
}

template <int PART> __device__ __forceinline__ void p0_weights(const Frame& F, const Params& p, int rank, int nranks) {
    PHASE_IDS
    float* scr = F.lds + wave * (64 * 33);
    const int gw = rank * NWAVES + wave, NGW = nranks * NWAVES;
    constexpr int I_QKV = 16 * 48, I_WO_ = 16 * 32, I_POOL = 4 * 8, I_WIN = 16 * 64, I_WOUT = 16 * 32, I_UP = 16 * 176, I_DN = 44 * 32;
#define P0_UP(l, r_) p0_transpose_item(IN(I_WUP) + (size_t)(l) * D * FF2, D, FF2, WSP(bf16_t, WS_WUP) + (size_t)(l) * FF2 * RP, RP, 0, scr, (r_), lane)
#define P0_QKV(j, r_) p0_transpose_item(IN(I_WQKV) + (size_t)(j) * D * QKVW, D, QKVW, WSP(bf16_t, WS_WQKV) + (size_t)(j) * QKVW * RP, RP, 0, scr, (r_), lane)
    if (PART == 0) {
        for (int it = gw; it < I_QKV + I_WO_ + 2 * I_UP; it += NGW) {
            int r = it;
            if (r < I_QKV) { P0_QKV(0, r); continue; } r -= I_QKV;
            if (r < I_WO_) { p0_transpose_item(IN(I_WO), D, D, WSP(bf16_t, WS_WO), RP, 0, scr, r, lane); continue; } r -= I_WO_;
            { const int l = r / I_UP; P0_UP(l, r % I_UP); }
        }
    } else if (PART == 1) {
        for (int it = gw; it < I_WO_ + 4 * I_POOL + I_WOUT + 4 * I_DN; it += NGW) {
            int r = it;
            if (r < I_WO_) { p0_transpose_item(IN(I_WO) + (size_t)D * D, D, D, WSP(bf16_t, WS_WO) + (size_t)D * RP, RP, 0, scr, r, lane); continue; } r -= I_WO_;
            if (r < 4 * I_POOL) { const int g = r / I_POOL; p0_transpose_item(IN(I_POOLW) + (size_t)g * 65536, 256, 256, WSP(bf16_t, WS_WPOOL), RPP, g * 256, scr, r % I_POOL, lane); continue; } r -= 4 * I_POOL;
            if (r < I_WOUT) { p0_transpose_item(IN(I_SWOUT), D, D, WSP(bf16_t, WS_WOUT), RP, 0, scr, r, lane); continue; } r -= I_WOUT;
            { const int l = r / I_DN; p0_transpose_item(IN(I_WDN) + (size_t)l * FF * D, FF, D, WSP(bf16_t, WS_WDN) + (size_t)l * D * FF, FF, 0, scr, r % I_DN, lane); }
        }
    } else if (PART == 2) {
        for (int it = gw; it < I_WIN; it += NGW) p0_transpose_item(IN(I_SWIN), D, 2048, WSP(bf16_t, WS_WIN), RP, 0, scr, it, lane);
    } else if (PART == 3) {
        for (int it = gw; it < I_UP; it += NGW) P0_UP(2, it);
    } else {
        for (int it = gw; it < I_QKV + I_UP; it += NGW) { if (it < I_QKV) P0_QKV(1, it); else P0_UP(3, it - I_QKV); }
    }
#undef P0_UP
#undef P0_QKV
}

__device__ __forceinline__ void p0_mod(const Frame& F, const Params& p, int layer, int rank, int nranks) {
    PHASE_IDS
    float* sv = F.lds;
    float* red = F.lds + 5 * 1024;
    const float* cvec = IN(I_C); const float* cctx = IN(I_CCTX); const float* ada_w = IN(I_ADAW); const float* ada_b = IN(I_ADAB); float* MOD = WSP(float, WS_MOD);
    for (int i = tid; i < 5 * 1024; i += NT) { const int v = i >> 10, k = i & 1023; const float xv = v < 4 ? cvec[v * D + k] : cctx[k]; sv[i] = silu_f(xv); }
    __syncthreads();
    const int cg4 = tid & 7, kr = tid >> 3;
    for (int item = rank; item < 192; item += nranks) {
        const int n0 = item * 32;
        const float* W = ada_w + (size_t)layer * D * 6144 + n0 + cg4 * 4;
        float acc[5][4];
#pragma unroll
        for (int v = 0; v < 5; ++v)
#pragma unroll
            for (int j = 0; j < 4; ++j) acc[v][j] = 0.f;
#pragma unroll 8
        for (int k = kr; k < D; k += 64) {
            const f32x4 w_ = __builtin_nontemporal_load((const f32x4*)(W + (size_t)k * 6144)); const float4 w = {w_[0], w_[1], w_[2], w_[3]};
#pragma unroll
            for (int v = 0; v < 5; ++v) { const float s = sv[v * 1024 + k]; acc[v][0] += s * w.x; acc[v][1] += s * w.y; acc[v][2] += s * w.z; acc[v][3] += s * w.w; }
        }
        __syncthreads();
#pragma unroll
        for (int v = 0; v < 5; ++v)
#pragma unroll
            for (int j = 0; j < 4; ++j) red[(kr * 5 + v) * 32 + cg4 * 4 + j] = acc[v][j];
        __syncthreads();
        if (tid < 160) {
            const int v = tid >> 5, col = tid & 31;
            float s = 0.f;
            for (int q = 0; q < 64; ++q) s += red[(q * 5 + v) * 32 + col];
            MOD[(size_t)(layer * 5 + v) * 6144 + n0 + col] = s + ada_b[layer * 6144 + n0 + col];
        }
        __syncthreads();
    }
}

__device__ __forceinline__ void final_norm(const Frame& F, const float* fnw) {
    PHASE_IDS
    const bf16_t* XB = WSP(bf16_t, WS_XB);
    for (int r2 = bid * 8 + wave; r2 < NLAT / 2; r2 += G * 8) {
        u32x2 w[2][4];
#pragma unroll
        for (int q = 0; q < 2; ++q)
#pragma unroll
            for (int j = 0; j < 4; ++j) w[q][j] = *(const u32x2*)(XB + (size_t)(2 * r2 + q) * RP + j * 256 + lane * 4);
#pragma unroll
        for (int q = 0; q < 2; ++q) { float* orow = F.X + (size_t)(2 * r2 + q) * D; f32x4 xv[4]; float ss = 0.f;
#pragma unroll
            for (int j = 0; j < 4; ++j) { xv[j] = unpkh4(w[q][j]); ss += (xv[j][0] * xv[j][0] + xv[j][1] * xv[j][1]) + (xv[j][2] * xv[j][2] + xv[j][3] * xv[j][3]); }
            const float rs = rsqrtf(wave_sum(ss) * (1.f / D) + EPS);
#pragma unroll
            for (int j = 0; j < 4; ++j) { const int c = j * 256 + lane * 4; __builtin_nontemporal_store(xv[j] * rs * *(const f32x4*)(fnw + c), (f32x4*)(orow + c)); } }
    }
}


__device__ __forceinline__ void p0_rope(const Frame& F) {
    PHASE_IDS
    if (bid < 16 && tid < 64) { float* rc = WSP(float, WS_ROPE); float* rsn = rc + 1024;
        { const int i = bid * 64 + tid; const int pos = i >> 4, fi = i & 15; const float ang = (float)pos * powf(10000.f, -(float)fi / 16.f); rc[i] = cosf(ang); rsn[i] = sinf(ang); } }
}
__device__ __forceinline__ void attn_phase(const Frame& F, const float* qg, const float* kg, bool with_ctx) {
    PHASE_IDS
    float gqm = 0.f, gkm = 0.f;
    for (int i = 0; i < HD; ++i) { gqm = fmaxf(gqm, fabsf(qg[i])); gkm = fmaxf(gkm, fabsf(kg[i])); }
    const float m2 = 8.f * gqm * gkm * 1.4426950408889634f;
    bf16_t* Q = WSP(bf16_t, WS_Q); const bf16_t* K = WSP(bf16_t, WS_K); const bf16_t* V = WSP(bf16_t, WS_V);
    const int vcu = (G % 8 == 0) ? (bid % 8) * (G / 8) + bid / 8 : bid;
    for (int s = vcu; s < 256; s += G) {
        const int pair = s >> 4, b = pair >> 2, kvh = pair & 3, qb = s & 15;
        attn_body::attn_unit(b * L + qb * 256, kvh * 4, 4, b * (LC + L), kvh, (LC + L) / 64, m2, Q, K, V, (char*)F.lds);
    }
    if (with_ctx) for (int s = vcu; s < 64; s += G) { const int b = s >> 4, h = s & 15; attn_body::attn_unit(NLAT + b * LC, h, 1, b * (LC + L), h >> 2, LC / 64, m2, Q, K, V, (char*)F.lds); }
}


template <int SET> __device__ __forceinline__ void bias_gemv(const Frame& F, int rank, int nranks) {
    PHASE_IDS
    const int gw = rank * NWAVES + wave, NGW = nranks * NWAVES;
    const float* MOD = WSP(float, WS_MOD); float* BW = WSP(float, WS_BIASW);
    LAS bf16_t* shb = (LAS bf16_t*)F.lds3;
    constexpr int NSEG = SET == 1 ? 1 : 2; constexpr int SEGA = SET == 0 ? 0 : SET == 1 ? 4 : SET == 2 ? 2 : 1, SEGB = SET == 0 ? 3 : SET == 2 ? 5 : 6;
    for (int i = tid; i < NSEG * 5 * 256; i += NT) { const int si = i / 1280, r = i % 1280, v = r >> 8, k4 = (r & 255) * 4;
        const int seg = si == 0 ? SEGA : SEGB;
        const int layer = seg < 2 ? 3 * seg : seg == 2 ? 2 : seg - 3, part = seg < 3 ? 0 : 3;
        const f32x4 x = *(const f32x4*)(MOD + ((size_t)(layer * 5 + v) * 6 + part) * D + k4);
        u32x2 w; w.x = pk2(x[0], x[1]); w.y = pk2(x[2], x[3]); *(LAS u32x2*)(shb + (seg * 5 + v) * 1024 + k4) = w; }
    __syncthreads();
    const int fr = lane & 15, fq = lane >> 4;
    constexpr int NG_QKV = QKVW / 16, NG_WIN = 2048 / 16, NG_UP = FF2 / 16, NGA = SEGA < 2 ? NG_QKV : SEGA == 2 ? NG_WIN : NG_UP, NG_ALL = NGA + (NSEG == 2 ? NG_UP : 0);
    for (int gi = gw; gi < NG_ALL; gi += NGW) {
        int seg, grp; const bf16_t* Wt; int N;
        if (gi < NGA) { seg = SEGA; grp = gi; } else { seg = SEGB; grp = gi - NGA; }
        if (seg < 2) { Wt = WSP(bf16_t, WS_WQKV) + (size_t)seg * QKVW * RP; N = QKVW; } else if (seg == 2) { Wt = WSP(bf16_t, WS_WIN); N = 2048; } else { Wt = WSP(bf16_t, WS_WUP) + (size_t)(seg - 3) * FF2 * RP; N = FF2; }
        const bf16_t* wrow = Wt + (size_t)(grp * 16 + fr) * RP + 8 * fq;
        const LAS bf16_t* srow = shb + (seg * 5 + (fr < 5 ? fr : 0)) * 1024 + 8 * fq;
        f32x4 acc = {0.f, 0.f, 0.f, 0.f};
#pragma unroll
        for (int kb = 0; kb < 4; ++kb) { bf16x8 bfr[8];
#pragma unroll
            for (int j = 0; j < 8; ++j) bfr[j] = *(const bf16x8*)(wrow + (kb * 8 + j) * 32);
#pragma unroll
            for (int j = 0; j < 8; ++j) { bf16x8 afr = *(const LAS bf16x8*)(srow + (kb * 8 + j) * 32); if (fr >= 5) afr = (bf16x8){0, 0, 0, 0, 0, 0, 0, 0};
                acc = __builtin_amdgcn_mfma_f32_16x16x32_bf16(afr, bfr[j], acc, 0, 0, 0); } }
        const int n = grp * 16 + fr; float* out = seg < 2 ? BW + BW_QKV + (size_t)seg * 5 * QKVW : seg == 2 ? BW + BW_WIN : BW + BW_UP + (size_t)(seg - 3) * 5 * FF2;
        const int half = n >= FF, f = n - half * FF;
#pragma unroll
        for (int reg = 0; reg < 4; ++reg) { const int v = 4 * fq + reg;
            if (v < 5) { if (seg < 3) out[(size_t)v * N + n] = acc[reg]; else out[((size_t)v * 22 + (f >> 7)) * 256 + half * 128 + (f & 127)] = acc[reg]; } }
    }
    __syncthreads();
}

__device__ __forceinline__ void p1_prep(const Frame& F, const Params& p) {
    PHASE_IDS
    const int gw = bid * NWAVES + wave, NGW = G * NWAVES;
    const float* MOD = WSP(float, WS_MOD); float* BW = WSP(float, WS_BIASW);
    bias_gemv<0>(F, bid, G);
    {
        const float* cw = IN(I_CONVW); const float* cb = IN(I_CONVB); float* CP = BW + BW_CONVP;
        for (int i = bid * NT + tid; i < 4 * 22 * 1024; i += G * NT) { const int l = i / (22 * 1024), r = i % (22 * 1024), pn = r >> 10, k = (r >> 8) & 3, half = (r >> 7) & 1, e = r & 127;
            const int col = half * FF + pn * 128 + e; CP[i] = (k < 3 ? cw[(size_t)(l * 3 + k) * FF2 + col] : cb[(size_t)l * FF2 + col]) * (half ? -1.4426950408889634f : -0.6931471805599453f); }
        if (bid == 0) { const float* qg = IN(I_QG); const float* kg = IN(I_KG); float* GP = BW + BW_GAINP;
            for (int i = tid; i < 512; i += NT) { const int j = i >> 8, e = i & 255; GP[i] = e < 64 ? qg[j * 64 + e] : e < 128 ? kg[j * 64 + e - 64] : 0.f; } }
    }
    {
        const float* xl = IN(I_X); const float* xc = IN(I_CTX); const float* nw = IN(I_NORMW); bf16_t* H = WSP(bf16_t, WS_H); float* PARTX = WSP(float, WS_PARTX);
        for (int r2 = gw; r2 < NTOK / 2; r2 += NGW) {
            f32x4 xv[2][4]; float ss[2] = {0.f, 0.f};
#pragma unroll
            for (int q = 0; q < 2; ++q) { const int r = 2 * r2 + q; const float* xr = r < NLAT ? xl + (size_t)r * D : xc + (size_t)(r - NLAT) * D;
#pragma unroll
                for (int jj = 0; jj < 4; ++jj) xv[q][jj] = __builtin_nontemporal_load((const f32x4*)(xr + jj * 256 + lane * 4)); }
#pragma unroll
            for (int q = 0; q < 2; ++q) { const int r = 2 * r2 + q; const float* sc = MOD + ((size_t)vidx(r) * 6 + 1) * D;
#pragma unroll
                for (int jj = 0; jj < 4; ++jj) { const int c = jj * 256 + lane * 4; const f32x4 x = xv[q][jj];
                    ss[q] += (x[0] * x[0] + x[1] * x[1]) + (x[2] * x[2] + x[3] * x[3]);
                    const f32x4 hv = x * (*(const f32x4*)(nw + c)) * (*(const f32x4*)(sc + c) + 1.f);
                    u32x2 w; w.x = pk2(hv[0], hv[1]); w.y = pk2(hv[2], hv[3]); *(u32x2*)(H + (size_t)r * RP + c) = w;
                    u32x2 xw; xw.x = pkh2(x[0], x[1]); xw.y = pkh2(x[2], x[3]); *(u32x2*)(WSP(bf16_t, WS_XB) + (size_t)r * RP + c) = xw; }
                const float t = wave_sum(ss[q]);
                if (lane < 4) PARTX[(size_t)r * 4 + lane] = lane == 0 ? t : 0.f; }
        }
    }
}

template <int WIN> __device__ __forceinline__ void pool_rows(const bf16_t* Hs, const LAS float* rsl, bf16_t* P, int r0, int half, int c, int sbase, int Ls) {
    f32x4 pre[32];
    u32x2 raw[31];
#pragma unroll
    for (int i = 0; i < 31; ++i) { int row = r0 + 16 * half - 8 + i; row = row < 0 ? 0 : (row > NTOK - 1 ? NTOK - 1 : row); raw[i] = *(const u32x2*)(Hs + (size_t)row * RP + c); }
    pre[0] = (f32x4){0.f, 0.f, 0.f, 0.f};
#pragma unroll
    for (int i = 0; i < 31; ++i) { const float rsv = rsl[16 * half + i];
        const f32x4 v = {__builtin_bit_cast(float, raw[i].x << 16), __builtin_bit_cast(float, raw[i].x & 0xffff0000u), __builtin_bit_cast(float, raw[i].y << 16), __builtin_bit_cast(float, raw[i].y & 0xffff0000u)};
        pre[i + 1] = pre[i] + v * rsv; }
#pragma unroll
    for (int q = 0; q < 16; ++q) {
        const int i = q + 8;
        const int t = r0 + 16 * half + q - sbase;
        int lo = t - WIN / 2; if (lo < 0) lo = 0;
        int hi = t + WIN - WIN / 2 - 1; if (hi > Ls - 1) hi = Ls - 1;
        const float ic = 1.f / (float)(hi - lo + 1);
        const f32x4 wsum = pre[i + WIN - WIN / 2] - pre[i - WIN / 2], self = pre[i + 1] - pre[i];
        const f32x4 o = wsum * ic - self;
        u32x2 w; w.x = pk2(o[0], o[1]); w.y = pk2(o[2], o[3]);
        *(u32x2*)(P + (size_t)(r0 + 16 * half + q) * RP + c) = w;
    }
}
__device__ __forceinline__ void pool_prep2(const Frame& F, const bf16_t* Hs, const float* PARTX, bf16_t* P) {
    PHASE_IDS
    LAS float* rsl = (LAS float*)F.lds3;
    const int half = tid >> 8, c = (tid & 255) * 4, g = (wave & 3);
    for (int tile = bid; tile < NTOK / 32; tile += G) {
        const int r0 = tile * 32; int sbase, Ls;
        if (r0 < NLAT) { sbase = r0 & ~(L - 1); Ls = L; } else { sbase = NLAT + ((r0 - NLAT) & ~(LC - 1)); Ls = LC; }
        __syncthreads();
        if (tid < 48) { const int rr = r0 - 8 + tid; float rsv = 0.f;
            if (rr >= sbase && rr < sbase + Ls) { const f32x4 q = *(const f32x4*)(PARTX + (size_t)rr * 4);
                rsv = rsqrtf(((q[0] + q[1]) + (q[2] + q[3])) * (1.f / D) + EPS); }
            rsl[tid] = rsv; }
        __syncthreads();
        if (g == 0) pool_rows<2>(Hs, rsl, P, r0, half, c, sbase, Ls);
        else if (g == 1) pool_rows<4>(Hs, rsl, P, r0, half, c, sbase, Ls);
        else if (g == 2) pool_rows<8>(Hs, rsl, P, r0, half, c, sbase, Ls);
        else pool_rows<16>(Hs, rsl, P, r0, half, c, sbase, Ls);
    }
    __syncthreads();
}

__device__ __forceinline__ void pool_prep_units(const Frame& F, const pg8::StaticOrder& S, const bf16_t* Hs, const float* PARTX, bf16_t* P) {
    PHASE_IDS
    LAS float* rsl = (LAS float*)F.lds3;
    for (int i = 0; ; ++i) { pg8::Unit u; if (!S.next(i, u)) break;
        const int rt = u.pm * 256, g = u.pn; int sbase, Ls;
        if (rt < NLAT) { sbase = rt & ~(L - 1); Ls = L; } else { sbase = NLAT + ((rt - NLAT) & ~(LC - 1)); Ls = LC; }
        __syncthreads();
        if (tid < 272) { const int rr = rt - 8 + tid; float rsv = 0.f;
            if (rr >= sbase && rr < sbase + Ls) { const f32x4 q = *(const f32x4*)(PARTX + (size_t)rr * 4);
                rsv = rsqrtf(((q[0] + q[1]) + (q[2] + q[3])) * (1.f / D) + EPS); }
            rsl[tid] = rsv; }
        __syncthreads();
        const int c = g * 256 + lane * 4;
#pragma unroll 1
        for (int k = 0; k < 2; ++k) { const int rb = wave + 8 * k;
            if (g == 0) pool_rows<2>(Hs, rsl, P, rt, rb, c, sbase, Ls);
            else if (g == 1) pool_rows<4>(Hs, rsl, P, rt, rb, c, sbase, Ls);
            else if (g == 2) pool_rows<8>(Hs, rsl, P, rt, rb, c, sbase, Ls);
            else pool_rows<16>(Hs, rsl, P, rt, rb, c, sbase, Ls); }
    }
    asm volatile("s_waitcnt vmcnt(0)" ::: "memory");
    __syncthreads();
}

__device__ __forceinline__ void final_fused(const Frame& F, const pg8::StreamOrder& S, const float* fnw) {
    PHASE_IDS
    pg8::Unit u; if (!S.next(0, u)) return;
    const int rt = u.pm * 256, c0 = u.pn * 256;
    LAS float* rsl = (LAS float*)F.lds3;
    asm volatile("s_waitcnt vmcnt(0)" ::: "memory"); __syncthreads();
    if (tid == 0) { unsigned* cw = (unsigned*)(F.ws + WS_ZERO) + u.pm * 16; __hip_atomic_fetch_add(cw, 1u, __ATOMIC_RELAXED, __HIP_MEMORY_SCOPE_AGENT); unsigned sp = 0;
        while (__hip_atomic_load(cw, __ATOMIC_RELAXED, __HIP_MEMORY_SCOPE_AGENT) < 4u) { __builtin_amdgcn_s_sleep(1); if (++sp > (1u << 22)) break; }
        __builtin_amdgcn_fence(__ATOMIC_ACQUIRE, "agent"); }
    __syncthreads();
    if (tid < 256) { const f32x4 q = *(const f32x4*)(WSP(float, WS_PARTX) + (size_t)(rt + tid) * 4); rsl[tid] = rsqrtf(((q[0] + q[1]) + (q[2] + q[3])) * (1.f / D) + EPS); }
    __syncthreads();
    const bf16_t* XB = WSP(bf16_t, WS_XB); const f32x4 fw = *(const f32x4*)(fnw + c0 + lane * 4);
#pragma unroll 1
    for (int rb = 0; rb < 2; ++rb) {
        u32x2 w[16];
#pragma unroll
        for (int i = 0; i < 16; ++i) w[i] = *(const u32x2*)(XB + (size_t)(rt + wave + NWAVES * (16 * rb + i)) * RP + c0 + lane * 4);
#pragma unroll
        for (int i = 0; i < 16; ++i) { const int r = wave + NWAVES * (16 * rb + i);
            __builtin_nontemporal_store(unpkh4(w[i]) * rsl[r] * fw, (f32x4*)(F.X + (size_t)(rt + r) * D + c0 + lane * 4)); }
    }
}

__global__ void __launch_bounds__(NT, 2) fwd_kernel(Params p) {
    extern __shared__ __attribute__((aligned(16))) unsigned char lds_raw[];
    cg::grid_group grid = cg::this_grid();
    Frame F;
    F.ws = p.ws; F.X = p.out;
    F.lds3 = (LAS unsigned char*)lds_raw; F.lds = (float*)lds_raw;
    const int G = gridDim.x, bid = blockIdx.x;
    for (int u = threadIdx.x; u < (LDS_BYTES - LDSCTL_OFF) / 4; u += NT) ((LAS unsigned*)(F.lds3 + LDSCTL_OFF))[u] = 0u;
    __syncthreads();
    volatile LAS unsigned* MISC = (volatile LAS unsigned*)(F.lds3 + MISC_OFF);
    XcdBarrier bar = xcd_barrier_post(WSP(unsigned, WS_CTL) + 1024, MISC + 8);
#define GRID_BAR() xcd_barrier(bar)
    const size_t STD_UNIT = (size_t)256 * RP * 2, STD_HALF = (size_t)128 * RP * 2;

    p0_weights<0>(F, p, (G == 256) ? (((bid & 64) ? 0 : 128) + (bid & 63) + ((bid >> 7) << 6)) : bid, G);
    __syncthreads();
    p0_mod(F, p, 0, bid, G); p0_mod(F, p, 1, (bid + G / 2) % G, G);
    p0_rope(F);
    GRID_BAR();
    p1_prep(F, p);
    GRID_BAR();
    if (p.ws == nullptr) grid.sync();
    for (int layer = 0; layer < DEPTH; ++layer) {
        int lg = G, lb = bid; asm volatile("" : "+s"(lg), "+s"(lb));
        const int kind = layer % 3, j = layer / 3; const bool last = layer == DEPTH - 1;
        const int nrows_res = last ? NLAT : NTOK;
        const float* mod_layer = WSP(float, WS_MOD) + (size_t)layer * 5 * 6144;
        if (kind == 0) {
            { PHASE_IDS const float* rt_ = WSP(float, WS_ROPE); *(LAS f32x4*)(F.lds3 + ROPE_OFF + tid * 16) = *(const f32x4*)(rt_ + tid * 4); }
            { pg8::Gemm g{WSP(bf16_t, WS_H), WSP(bf16_t, WS_WQKV) + (size_t)j * QKVW * RP, RP, RP, D, 0, STD_UNIT, (size_t)16 * RP * 2}; pg8::StaticOrder S; S.init(NTOK, QKVW, lg, lb);
              EpiQKV E{WSP(bf16_t, WS_Q), WSP(bf16_t, WS_K), (WS_V - WS_K) / 2, WSP(float, WS_BIASW) + BW_GAINP + (size_t)j * 256, WSP(float, WS_PARTX), WSP(float, WS_BIASW) + BW_QKV + (size_t)j * 5 * QKVW, (LAS float*)(F.lds3 + PRM_OFF), (const LAS float*)(F.lds3 + ROPE_OFF)};
              pg8::gemm_phase<EpiQKV, pg8::StaticOrder, true>(F.lds3, g, S, E); }
            if (layer == 0) { int fi = (NTOK / 256) * (QKVW / 256) - G; if (fi < 0 || fi >= G) fi = 0;
                if (bid >= fi) { __syncthreads(); p0_weights<1>(F, p, bid - fi, G - fi); } }
            GRID_BAR();
            attn_phase(F, IN(I_QG) + j * HD, IN(I_KG) + j * HD, !last);
            GRID_BAR();
            { pg8::Gemm g{WSP(bf16_t, WS_Q), WSP(bf16_t, WS_WO) + (size_t)j * D * RP, RP, RP, D, 0, STD_UNIT, STD_HALF}; pg8::StreamOrder S0, S; S0.init(nrows_res, D, D, lg, lb, 0); S.init(nrows_res, D, D, lg, lb, 1);
              EpiResid<false> E{WSP(bf16_t, WS_XB), mod_layer, 2, nullptr, nullptr, WSP(bf16_t, WS_H), WSP(float, WS_PARTX), IN(I_NORMW) + (size_t)(layer * 2 + 1) * D, mod_layer, 4, (LAS float*)(F.lds3 + XB_OFF + 2048), (LAS float*)(F.lds3 + PRM_OFF)};
              EpiTailT<EpiResid<false>> ET{WSP(float, WS_BIG1), (unsigned*)(F.ws + WS_SFLAG + (size_t)j * SFLAG_PHASE)}; pg8::gemm_phase<EpiTailT<EpiResid<false>>, pg8::StreamOrder, true>(F.lds3, g, S0, ET);
              EpiHead<EpiResid<false>> ES{E, WSP(float, WS_BIG1), (unsigned*)(F.ws + WS_SFLAG + (size_t)j * SFLAG_PHASE), F.lds3};
              pg8::gemm_phase<EpiHead<EpiResid<false>>, pg8::StreamOrder, true>(F.lds3, g, S, ES); }
            GRID_BAR();
        } else if (kind == 1) {
            { pg8::Gemm g{WSP(bf16_t, WS_BIG2), WSP(bf16_t, WS_WPOOL), RP, RPP, 256, (size_t)256 * 2, (size_t)256 * RPP * 2, (size_t)128 * RPP * 2}; pg8::StaticOrder S; S.init(nrows_res, D, lg, lb);
              pool_prep_units(F, S, WSP(bf16_t, WS_H), WSP(float, WS_PARTX), WSP(bf16_t, WS_BIG2));
              EpiResid<true> E{WSP(bf16_t, WS_XB), mod_layer, 2, IN(I_POOLB) + (size_t)j * D, IN(I_POOLS) + (size_t)j * D, WSP(bf16_t, WS_H), WSP(float, WS_PARTX), IN(I_NORMW) + (size_t)(layer * 2 + 1) * D, mod_layer, 4, (LAS float*)(F.lds3 + XB_OFF + 2048), (LAS float*)(F.lds3 + PRM_OFF)};
              pg8::gemm_phase<EpiResid<true>, pg8::StaticOrder, true>(F.lds3, g, S, E); }
            { const int nwg_ = (nrows_res / 256) * 4; int fi = nwg_ - ((nwg_ - 1) / G) * G; if (fi < 0 || fi >= G) fi = 0;
              if (bid >= fi && layer + 1 < DEPTH) { __syncthreads(); p0_mod(F, p, layer + 1, bid - fi, G - fi); __syncthreads(); p0_weights<3>(F, p, bid - fi, G - fi); } }
            GRID_BAR();
        } else {
            { pg8::Gemm g{WSP(bf16_t, WS_H), WSP(bf16_t, WS_WIN), RP, RP, D, 0, STD_UNIT, STD_HALF}; pg8::StaticOrder S; S.init(nrows_res, 2048, lg, lb);
              EpiGelu E{WSP(bf16_t, WS_SU), WSP(bf16_t, WS_SV), WSP(float, WS_SPART), WSP(float, WS_PARTX), WSP(float, WS_BIASW) + BW_WIN, (LAS float*)(F.lds3 + PRM_OFF)}; pg8::gemm_phase<EpiGelu, pg8::StaticOrder, true>(F.lds3, g, S, E); }
            { const int nwg_ = (nrows_res / 256) * 8; int fi = nwg_ - ((nwg_ - 1) / G) * G; if (fi < 0 || fi >= G) fi = 0;
              if (bid >= fi && layer + 1 < DEPTH) { __syncthreads(); p0_mod(F, p, layer + 1, bid - fi, G - fi); __syncthreads(); p0_weights<4>(F, p, bid - fi, G - fi); } }
            GRID_BAR();
            sgu_spatial(F, IN(I_SWS) + (size_t)j * 8 * 16384, IN(I_SBS) + (size_t)j * 8 * 128, IN(I_SVG) + (size_t)j * D, WSP(bf16_t, WS_SU), WSP(bf16_t, WS_SV), WSP(float, WS_SPART), WSP(bf16_t, WS_BIG2), nrows_res);
            GRID_BAR();
            { pg8::Gemm g{WSP(bf16_t, WS_BIG2), WSP(bf16_t, WS_WOUT), RP, RP, D, 0, STD_UNIT, STD_HALF}; pg8::StreamOrder S0, S; S0.init(nrows_res, D, D, lg, lb, 0); S.init(nrows_res, D, D, lg, lb, 1);
              EpiResid<false> E{WSP(bf16_t, WS_XB), mod_layer, 2, nullptr, nullptr, WSP(bf16_t, WS_H), WSP(float, WS_PARTX), IN(I_NORMW) + (size_t)(layer * 2 + 1) * D, mod_layer, 4, (LAS float*)(F.lds3 + XB_OFF + 2048), (LAS float*)(F.lds3 + PRM_OFF)};
              EpiTailT<EpiResid<false>> ET{WSP(float, WS_BIG1), (unsigned*)(F.ws + WS_SFLAG + (size_t)2 * SFLAG_PHASE)}; pg8::gemm_phase<EpiTailT<EpiResid<false>>, pg8::StreamOrder, true>(F.lds3, g, S0, ET);
              EpiHead<EpiResid<false>> ES{E, WSP(float, WS_BIG1), (unsigned*)(F.ws + WS_SFLAG + (size_t)2 * SFLAG_PHASE), F.lds3};
              pg8::gemm_phase<EpiHead<EpiResid<false>>, pg8::StreamOrder, true>(F.lds3, g, S, ES); }
            GRID_BAR();
        }
        const bool fuse_fin = last && G * 256 == NLAT * 4;
        { pg8::Gemm g{WSP(bf16_t, WS_H), WSP(bf16_t, WS_WUP) + (size_t)layer * FF2 * RP, RP, RP, D, 0, (size_t)128 * RP * 2, (size_t)FF * RP * 2}; pg8::StaticOrder S; S.init(nrows_res, FF2, lg, lb);
          EpiUpConv E{WSP(bf16_t, WS_BIG1), WSP(float, WS_EDGE), WSP(float, WS_BIASW) + BW_CONVP + (size_t)layer * 22 * 1024, (LAS float*)(F.lds3 + XB_OFF), WSP(float, WS_PARTX), WSP(float, WS_BIASW) + BW_UP + (size_t)layer * 5 * FF2, (LAS float*)(F.lds3 + PRM_OFF), WSP(unsigned, WS_EFLAG) + (size_t)layer * EFLAG_LAYER};
          pg8::gemm_phase<EpiUpConv, pg8::StaticOrder, true>(F.lds3, g, S, E);
          up_edge_fix(S, IN(I_CONVW) + (size_t)layer * 3 * FF2, IN(I_CONVB) + (size_t)layer * FF2, WSP(float, WS_EDGE), WSP(bf16_t, WS_BIG1), WSP(unsigned, WS_EFLAG) + (size_t)layer * EFLAG_LAYER, (LAS unsigned*)(F.lds3 + MISC_OFF + 64)); }
        if (!last) { const int nwg_ = (nrows_res / 256) * 22; int fi = nwg_ - ((nwg_ - 1) / G) * G; if (fi < 0 || fi >= G) fi = 0;
            if (bid >= fi) { __syncthreads(); if (layer == 0) { bias_gemv<1>(F, bid - fi, G - fi); p0_weights<2>(F, p, bid - fi, G - fi); } else if (layer == 1) bias_gemv<2>(F, bid - fi, G - fi); else bias_gemv<3>(F, bid - fi, G - fi); } }
        GRID_BAR();
        { pg8::Gemm g{WSP(bf16_t, WS_BIG1), WSP(bf16_t, WS_WDN) + (size_t)layer * D * FF, FF, FF, FF, 0, (size_t)256 * FF * 2, (size_t)128 * FF * 2}; pg8::StreamOrder S0, S; S0.init(nrows_res, D, FF, lg, lb, 0); S.init(nrows_res, D, FF, lg, lb, 1);
          EpiResid<false, true> E{WSP(bf16_t, WS_XB), mod_layer, 5, nullptr, nullptr, last ? nullptr : WSP(bf16_t, WS_H), WSP(float, WS_PARTX), IN(I_NORMW) + (size_t)((layer + 1) * 2) * D, WSP(float, WS_MOD) + (size_t)(layer + 1) * 5 * 6144, fuse_fin ? 99 : 1, (LAS float*)(F.lds3 + XB_OFF + 2048), (LAS float*)(F.lds3 + PRM_OFF)};
          EpiTailT<EpiResid<false, true>> ET{WSP(float, WS_BIG2), (unsigned*)(F.ws + WS_SFLAG + (size_t)(3 + layer) * SFLAG_PHASE)}; pg8::gemm_phase<EpiTailT<EpiResid<false, true>>, pg8::StreamOrder, true>(F.lds3, g, S0, ET);
              EpiHead<EpiResid<false, true>> ES{E, WSP(float, WS_BIG2), (unsigned*)(F.ws + WS_SFLAG + (size_t)(3 + layer) * SFLAG_PHASE), F.lds3};
              pg8::gemm_phase<EpiHead<EpiResid<false, true>>, pg8::StreamOrder, true>(F.lds3, g, S, ES);
              if (fuse_fin) { final_fused(F, S, IN(I_FNORM)); return; } }
        GRID_BAR();
    }
    final_norm(F, IN(I_FNORM));
}

extern "C" void kernel_launch(void* const* d_in, const int* in_sizes, int n_in, void* d_out, int out_size, void* d_ws, size_t ws_size, hipStream_t stream) {
    constexpr size_t kDynLds = LDS_BYTES;
    static int grid_blocks = 0;
    if (!grid_blocks) {
        int dev = 0, cus = 0, per_cu = 0;
        (void)hipGetDevice(&dev);
        (void)hipDeviceGetAttribute(&cus, hipDeviceAttributeMultiprocessorCount, dev);
        (void)hipFuncSetAttribute((const void*)fwd_kernel, hipFuncAttributeMaxDynamicSharedMemorySize, (int)kDynLds);
        (void)hipOccupancyMaxActiveBlocksPerMultiprocessor(&per_cu, fwd_kernel, NT, kDynLds);
        if (per_cu < 1) fprintf(stderr, "occupancy query returned %d\n", per_cu);
        grid_blocks = cus;
        if (ws_size < WS_END) fprintf(stderr, "workspace too small: %zu < %zu\n", ws_size, (size_t)WS_END);
    }
    (void)hipMemsetAsync((char*)d_ws + WS_CTL, 0, CTL_ZERO_BYTES, stream);
    Params p{};
    for (int i = 0; i < 24; ++i) p.in[i] = (const float*)d_in[i];
    p.out = (float*)d_out; p.ws = (unsigned char*)d_ws;
    void* args[] = {&p};
    hipError_t e = hipLaunchCooperativeKernel((void*)fwd_kernel, dim3(grid_blocks), dim3(NT), args, kDynLds, stream);
    if (e != hipSuccess) fprintf(stderr, "cooperative launch failed: %s (grid %d)\n", hipGetErrorString(e), grid_blocks);
}
```

```cpp
#include <hip/hip_runtime.h>
#include <hip/hip_cooperative_groups.h>
#include <cstdio>
#include <cstdint>
namespace cg = cooperative_groups;

constexpr int D = 1024, NB = 4, L = 4096, LC = 256, DEPTH = 4;
constexpr int NLAT = NB * L, NCTX = NB * LC, NTOK = NLAT + NCTX;
constexpr int FF = 2816, FF2 = 5632;
constexpr int NH = 16, HD = 64, NKV = 4, QKVW = 1536;
constexpr float EPS = 1e-6f;
constexpr int NT = 512;
constexpr int NWAVES = 8;
constexpr int RP = 1152;
constexpr int RPP = 288;

#define LAS __attribute__((address_space(3)))
typedef unsigned short bf16_t;
typedef short bf16x8 __attribute__((ext_vector_type(8)));
typedef float f32x4 __attribute__((ext_vector_type(4)));
typedef unsigned u32x4 __attribute__((ext_vector_type(4)));
typedef unsigned u32x2 __attribute__((ext_vector_type(2)));

__device__ __forceinline__ unsigned f2bf(float f) { unsigned u = __builtin_bit_cast(unsigned, f); return (u + 0x7fffu + ((u >> 16) & 1u)) >> 16; }
typedef float f32x2_c __attribute__((ext_vector_type(2))); typedef __bf16 bf16x2_c __attribute__((ext_vector_type(2)));
__device__ __forceinline__ unsigned pk2(float lo, float hi) { f32x2_c v = {lo, hi}; bf16x2_c b = __builtin_convertvector(v, bf16x2_c); return __builtin_bit_cast(unsigned, b); }
typedef _Float16 h16x2_c __attribute__((ext_vector_type(2)));
__device__ __forceinline__ unsigned pkh2(float lo, float hi) { unsigned a, b; asm("v_cvt_f16_f32 %0, %1" : "=v"(a) : "v"(lo)); asm("v_cvt_f16_f32 %0, %1" : "=v"(b) : "v"(hi));
    return (a & 0xffffu) | (b << 16); }
__device__ __forceinline__ f32x4 unpkh4(u32x2 w) {
    float a, b, c, d; const unsigned hx = w.x >> 16, hy = w.y >> 16;
    asm("v_cvt_f32_f16 %0, %1" : "=v"(a) : "v"(w.x)); asm("v_cvt_f32_f16 %0, %1" : "=v"(b) : "v"(hx));
    asm("v_cvt_f32_f16 %0, %1" : "=v"(c) : "v"(w.y)); asm("v_cvt_f32_f16 %0, %1" : "=v"(d) : "v"(hy));
    return (f32x4){a, b, c, d};
}
__device__ __forceinline__ float bf2f(unsigned short b) { return __builtin_bit_cast(float, (unsigned)b << 16); }

namespace pg8 {
constexpr int BM = 256, BK = 64, HALF = 128, HTB = HALF * BK * 2, STAGE_BYTES = 8 * HTB, NXCD = 8, WGM = 8;
__host__ __device__ __forceinline__ int lds_byte(int r, int c) { const int st = (r >> 4) * 2 + (c >> 5), rr = r & 15, cc = c & 31, ob = rr * 64 + cc * 2; return st * 1024 + (ob ^ (((ob >> 9) & 1) << 5)); }
__host__ __device__ __forceinline__ void stage_rc(int b, int& R, int& C) { const int st = b / 1024, sb = b % 1024, swz = sb ^ (((sb >> 9) & 1) << 5); R = (st >> 1) * 16 + swz / 64; C = (st & 1) * 32 + (swz % 64) / 2; }

struct Unit { int pm, pn; int kt0, nkt  ; int rng  ; int role  ; };
struct Gemm { const bf16_t* A; const bf16_t* Bt; int lda, ldb, K; size_t a_pn_step, b_unit_step, b_half_step; };

struct StaticOrder {
    int nM, nN, nwg, G, c;
    __host__ __device__ __forceinline__ void init(int M, int N, int G_, int c_) { nM = M / BM; nN = N / BM; nwg = nM * nN; G = G_; c = c_; }
    __host__ __device__ __forceinline__ bool next(int i, Unit& u) const {
        const long Lx = (long)i * G + c; if (Lx >= nwg) return false;
        int wgid = (int)Lx; { const int q = nwg / NXCD, r = nwg % NXCD, xcd = wgid % NXCD, off = wgid / NXCD; wgid = (xcd < r ? xcd * (q + 1) : r * (q + 1) + (xcd - r) * q) + off; }
        const int nig = WGM * nN, gid = wgid / nig, fm = gid * WGM, gsz = (nM - fm) < WGM ? (nM - fm) : WGM;
        u.pm = fm + ((wgid % nig) % gsz); u.pn = (wgid % nig) / gsz; u.kt0 = 0; u.nkt = 0; u.rng = 0; u.role = 0; return true;
    }
};


struct StreamOrder {
    int nN, nkt, nblk, r, s, e;
    int mode;
    __host__ __device__ __forceinline__ void init(int M, int N, int K, int G, int c, int mode_) { mode = mode_; const int nM = M / BM; nN = N / BM; nkt = K / BK; nblk = nM * nN / 16;
        const int x = c % 8, i = c / 8; r = (G == 256) ? (2 * x + (i & 1)) + 16 * (i >> 1) : c;
        const long q = (long)nM * nN * nkt / 4; s = 4 * (int)((long)r * q / G); e = 4 * (int)((long)(r + 1) * q / G); }
    __host__ __device__ __forceinline__ bool next(int i, Unit& u) const {
        const bool has_tail = (s % nkt) != 0;
        if (mode == 0) { if (i > 0 || !has_tail) return false; } else if (has_tail) ++i;
        int p = s; for (int k = 0; k < i; ++k) { const int ue = (p / nkt + 1) * nkt; p = ue < e ? ue : e; }
        if (p >= e) return false;
        const int ui = p / nkt, kt0 = p % nkt, ue = (ui + 1) * nkt, pe = ue < e ? ue : e;
        const int k = ui / nblk, j = ui % nblk, ncb = nN / 4, jb = j / ncb, jc = j % ncb;
        u.pm = 4 * jb + (k & 3); u.pn = 4 * jc + (k >> 2); u.kt0 = kt0; u.nkt = pe - p; u.rng = r; u.role = (kt0 == 0 && pe == ue) ? 0 : (kt0 > 0 ? 1 : 2);
        return true;
    }
};

template <class Epi, class Sched, bool ALIGN_EPI>
__device__ __forceinline__ void gemm_phase(LAS unsigned char* lds, const Gemm g, const Sched& S, const Epi& E) {
    int tid = threadIdx.x; asm volatile("" : "+v"(tid));
    const int wid = __builtin_amdgcn_readfirstlane(tid >> 6), lane = tid & 63, wr = wid >> 2, wc = wid & 3, fr = lane & 15, fq = lane >> 4;
    int K = g.K; asm volatile("" : "+s"(K));
    const int nt_full = K / BK;
    unsigned voffA[2], voffB[2];
#pragma unroll
    for (int i = 0; i < 2; ++i) { int R, C; stage_rc(tid * 16 + i * 8192, R, C); const int Rb = Epi::brow(R);
        voffA[i] = (unsigned)(R * g.lda + C) * 2u; voffB[i] = (unsigned)(Rb * g.ldb + C) * 2u; }
    const size_t kstep = (size_t)(BK * 2);
    const size_t hstepA = (size_t)HALF * g.lda * 2, tstepA = 2 * hstepA, hstepB = g.b_half_step;
    const unsigned ldsw = (unsigned)wid * 1024u;
    const int aoff = lds_byte(wr * 64 + fr, fq * 8), boff = lds_byte(wc * 32 + fr, fq * 8);
#define PG8_SA(b, h) (((b) * 2 + (h)) * HTB)
#define PG8_SB(b, h) ((4 + (b) * 2 + (h)) * HTB)
#define PG8_STAGE(bufoff, gbase, voff) do { _Pragma("unroll") for (int _i = 0; _i < 2; ++_i) \
        __builtin_amdgcn_global_load_lds((const unsigned*)((const char*)(gbase) + (voff)[_i]), (LAS unsigned*)(lds + (bufoff) + ldsw + _i * 8192), 16, 0, 0); } while (0)
#define PG8_LDA(dst, b, h) do { _Pragma("unroll") for (int m = 0; m < 4; ++m) _Pragma("unroll") for (int k = 0; k < 2; ++k) dst[m][k] = *(const LAS bf16x8*)(lds + PG8_SA(b, h) + aoff + m * 2048 + k * 1024); } while (0)
#define PG8_LDB(dst, b, h) do { _Pragma("unroll") for (int n = 0; n < 2; ++n) _Pragma("unroll") for (int k = 0; k < 2; ++k) dst[n][k] = *(const LAS bf16x8*)(lds + PG8_SB(b, h) + boff + n * 2048 + k * 1024); } while (0)
#define PG8_MMA(ai, bj, At, Bt) do { __builtin_amdgcn_s_setprio(1); _Pragma("unroll") for (int m = 0; m < 4; ++m) _Pragma("unroll") for (int n = 0; n < 2; ++n) _Pragma("unroll") for (int k = 0; k < 2; ++k) \
        acc[ai][bj][m][n] = __builtin_amdgcn_mfma_f32_16x16x32_bf16(Bt[n][k], At[m][k], acc[ai][bj][m][n], 0, 0, 0); __builtin_amdgcn_s_setprio(0); } while (0)
#define PG8_WAIT_V(n) asm volatile("s_waitcnt vmcnt(" #n ")" ::: "memory")
#define PG8_WAIT_L(n) asm volatile("s_waitcnt lgkmcnt(" #n ")" ::: "memory")
#define PG8_BAR __builtin_amdgcn_s_barrier()
#define PG8_SCHED __builtin_amdgcn_sched_barrier(0)
    Unit cur, nxt; int ui = 0;
    if (!S.next(0, cur)) return;
    f32x4 acc[2][2][4][2];
#pragma unroll
    for (int a = 0; a < 2; ++a)
#pragma unroll
        for (int b = 0; b < 2; ++b)
#pragma unroll
            for (int m = 0; m < 4; ++m)
#pragma unroll
                for (int n = 0; n < 2; ++n) acc[a][b][m][n] = (f32x4){0.f, 0.f, 0.f, 0.f};
    bf16x8 At[4][2], B0[2][2], B1[2][2];
    const char* cA = (const char*)g.A + (size_t)cur.pm * tstepA + (size_t)cur.pn * g.a_pn_step + (size_t)cur.kt0 * kstep; const char* cB = (const char*)g.Bt + (size_t)cur.pn * g.b_unit_step + (size_t)cur.kt0 * kstep;
    int nt = cur.nkt ? cur.nkt : nt_full;
    { int l2 = threadIdx.x; asm volatile("" : "+v"(l2)); l2 &= 63; E.prefetch(cur, wid, l2, 0); }
    PG8_STAGE(PG8_SB(0, 0), cB, voffB); PG8_STAGE(PG8_SB(0, 1), cB + hstepB, voffB); PG8_STAGE(PG8_SA(0, 0), cA, voffA); PG8_STAGE(PG8_SA(0, 1), cA + hstepA, voffA);
    if (wr == 1) PG8_BAR;
    PG8_WAIT_V(2); PG8_BAR;
    PG8_STAGE(PG8_SB(1, 0), cB + kstep, voffB); PG8_STAGE(PG8_SA(1, 0), cA + kstep, voffA); PG8_STAGE(PG8_SB(1, 1), cB + hstepB + kstep, voffB);
    PG8_WAIT_V(6); PG8_BAR;
    for (;;) {
        const bool has_next = S.next(ui + 1, nxt);
        const char* nA = has_next ? (const char*)g.A + (size_t)nxt.pm * tstepA + (size_t)nxt.pn * g.a_pn_step + (size_t)nxt.kt0 * kstep : cA; const char* nB = has_next ? (const char*)g.Bt + (size_t)nxt.pn * g.b_unit_step + (size_t)nxt.kt0 * kstep : cB;
        for (int t = 0; t < nt; t += 2) {
            const bool last = (t == nt - 2);
            const char* a1 = cA + (size_t)(t + 1) * kstep;
            const char* a2 = last ? nA : cA + (size_t)(t + 2) * kstep; const char* b2 = last ? nB : cB + (size_t)(t + 2) * kstep;
            const char* a3 = a2 + kstep; const char* b3 = b2 + kstep;
            PG8_LDB(B0, 0, 0); PG8_LDB(B1, 0, 1); PG8_SCHED; PG8_LDA(At, 0, 0); PG8_STAGE(PG8_SA(1, 1), a1 + hstepA, voffA);
            PG8_WAIT_V(8); PG8_WAIT_L(0); PG8_BAR; PG8_MMA(0, 0, At, B0); PG8_MMA(0, 1, At, B1); PG8_BAR; PG8_SCHED;
            PG8_LDA(At, 0, 1); PG8_STAGE(PG8_SB(0, 0), b2, voffB); PG8_STAGE(PG8_SB(0, 1), b2 + hstepB, voffB); PG8_STAGE(PG8_SA(0, 0), a2, voffA);
            PG8_WAIT_V(8); PG8_WAIT_L(0); PG8_BAR; PG8_MMA(1, 0, At, B0); PG8_MMA(1, 1, At, B1); PG8_BAR; PG8_SCHED;
            PG8_LDB(B0, 1, 0); PG8_LDB(B1, 1, 1); PG8_SCHED; PG8_LDA(At, 1, 0); PG8_STAGE(PG8_SA(0, 1), a2 + hstepA, voffA);
            PG8_WAIT_V(8); PG8_WAIT_L(0); PG8_BAR; PG8_MMA(0, 0, At, B0); PG8_MMA(0, 1, At, B1); PG8_BAR; PG8_SCHED;
            PG8_LDA(At, 1, 1); PG8_STAGE(PG8_SB(1, 0), b3, voffB); PG8_STAGE(PG8_SB(1, 1), b3 + hstepB, voffB); PG8_STAGE(PG8_SA(1, 0), a3, voffA);
            PG8_WAIT_V(8); PG8_WAIT_L(0); PG8_BAR; PG8_MMA(1, 0, At, B0); PG8_MMA(1, 1, At, B1); PG8_BAR; PG8_SCHED;
        }
        if constexpr (ALIGN_EPI) { if (wr == 0) PG8_BAR; }
        { int t2 = threadIdx.x; asm volatile("" : "+v"(t2));
          const int wid2 = __builtin_amdgcn_readfirstlane(t2 >> 6), lane2 = t2 & 63; E(acc, cur, wid2 >> 2, wid2 & 3, lane2 & 15, lane2 >> 4, ui & 1); }
        if (!has_next) break;
#pragma unroll
        for (int a = 0; a < 2; ++a)
#pragma unroll
            for (int b = 0; b < 2; ++b)
#pragma unroll
                for (int m = 0; m < 4; ++m)
#pragma unroll
                    for (int n = 0; n < 2; ++n) acc[a][b][m][n] = (f32x4){0.f, 0.f, 0.f, 0.f};
        cur = nxt; cA = nA; cB = nB; ++ui; nt = cur.nkt ? cur.nkt : nt_full;
        { int l2 = threadIdx.x; asm volatile("" : "+v"(l2)); l2 &= 63; E.prefetch(cur, wid, l2, ui & 1); }
        if constexpr (ALIGN_EPI) { if (wr == 1) PG8_BAR; }
    }
    PG8_WAIT_V(0);
    if constexpr (!ALIGN_EPI) { if (wr == 0) PG8_BAR; }
    PG8_BAR;
#undef PG8_SA
#undef PG8_SB
#undef PG8_STAGE
#undef PG8_LDA
#undef PG8_LDB
#undef PG8_MMA
#undef PG8_WAIT_V
#undef PG8_WAIT_L
#undef PG8_BAR
#undef PG8_SCHED
}
}

namespace attn_body {
using s16x4 = __attribute__((ext_vector_type(4))) short;
using f32x16 = __attribute__((ext_vector_type(16))) float;
constexpr int DM = RP, KP = 256, NW = 8, QBLK = 32, QB = 256, KVBLK = 64;
__device__ __forceinline__ int crow(int r, int hi) { return (r & 3) + 8 * (r >> 2) + 4 * hi; }
#define SBAR() __builtin_amdgcn_sched_barrier(0)
constexpr int NSLOT = 3, SLOTB = 8192;
constexpr int LDS_K = 0, LDS_V = NSLOT * SLOTB, LDS_WS = 2 * NSLOT * SLOTB, LDS_OST = LDS_WS + NW * 64 * 4, LDS_QST = LDS_OST + NW * 4096, LDS_BYTES_A = LDS_QST + NW * 4096;
constexpr float C2 = 0.125f * 1.4426950408889634f;
__device__ __forceinline__ void glds16(const void* gsrc, unsigned lds_dst) { unsigned keep;
    asm volatile("s_mov_b32 %0, m0\n\ts_mov_b32 m0, %2\n\ts_nop 0\n\tglobal_load_lds_dwordx4 %1, off\n\ts_mov_b32 m0, %0" : "=&s"(keep) : "v"(gsrc), "s"(lds_dst) : "memory"); }
typedef float f32x2_t __attribute__((ext_vector_type(2))); typedef __bf16 bf16x2_t __attribute__((ext_vector_type(2)));
__device__ __forceinline__ unsigned cvtpk_s(float lo, float hi) { f32x2_t v = {lo, hi}; bf16x2_t b = __builtin_convertvector(v, bf16x2_t); return __builtin_bit_cast(unsigned, b); }
#define WAIT_BAR(N) asm volatile("s_waitcnt vmcnt(" #N ") lgkmcnt(0)\n\ts_barrier" ::: "memory")
__device__ __forceinline__ void qkt(f32x16& p0, f32x16& p1, const char* Kslot, const bf16x8* qr, const f32x16& negm, int r32, int hi) {
    const int kb0 = r32 * 128 + ((hi ^ ((r32 >> 1) & 7)) * 16);
#pragma unroll
    for (int d0 = 0; d0 < 4; ++d0) {
        const bf16x8 b0 = *reinterpret_cast<const bf16x8*>(Kslot + (kb0 ^ (32 * d0)));
        const bf16x8 b1 = *reinterpret_cast<const bf16x8*>(Kslot + (kb0 ^ (32 * d0)) + 4096);
        if (d0 == 0) { p0 = __builtin_amdgcn_mfma_f32_32x32x16_bf16(b0, qr[0], negm, 0, 0, 0); p1 = __builtin_amdgcn_mfma_f32_32x32x16_bf16(b1, qr[0], negm, 0, 0, 0); }
        else { p0 = __builtin_amdgcn_mfma_f32_32x32x16_bf16(b0, qr[d0], p0, 0, 0, 0); p1 = __builtin_amdgcn_mfma_f32_32x32x16_bf16(b1, qr[d0], p1, 0, 0, 0); } }
}
typedef __attribute__((address_space(3))) const char* lds_cptr;
typedef short v4i16_t __attribute__((ext_vector_type(4)));
#define KLD(p) (*(const __attribute__((address_space(3))) bf16x8*)(p))
__device__ __forceinline__ void kload2(bf16x8* kf, lds_cptr kbase, int kb0, int slot, int j) { const lds_cptr kp = kbase + ((kb0 ^ (32 * j)) + slot); kf[2 * j] = KLD(kp); kf[2 * j + 1] = KLD(kp + 4096); }
__device__ __forceinline__ void kload8(bf16x8* kf, lds_cptr kbase, int kb0, int slot) { kload2(kf, kbase, kb0, slot, 0); kload2(kf, kbase, kb0, slot, 1); kload2(kf, kbase, kb0, slot, 2); kload2(kf, kbase, kb0, slot, 3); }
__device__ __forceinline__ s16x4 vtr(lds_cptr p) { return __builtin_bit_cast(s16x4, __builtin_amdgcn_ds_read_tr16_b64_v4i16((__attribute__((address_space(3))) v4i16_t*)p)); }
__device__ __forceinline__ void pv(f32x16* o, int vb, bf16x8 pa0, bf16x8 pa1, bf16x8 pa2, bf16x8 pa3) {
#pragma unroll
    for (int d0 = 0; d0 < 2; ++d0) { s16x4 lo[4], hi[4];
#pragma unroll
        for (int ks = 0; ks < 4; ++ks) {
            asm volatile("ds_read_b64_tr_b16 %0,%1 offset:%c2" : "=&v"(lo[ks]) : "v"(vb), "i"(d0 * 4096 + ks * 1024) : "memory");
            asm volatile("ds_read_b64_tr_b16 %0,%1 offset:%c2" : "=&v"(hi[ks]) : "v"(vb), "i"(d0 * 4096 + ks * 1024 + 512) : "memory"); }
        asm volatile("s_waitcnt lgkmcnt(0)" ::: "memory"); SBAR();
#define PK(k) (bf16x8){lo[k][0], lo[k][1], lo[k][2], lo[k][3], hi[k][0], hi[k][1], hi[k][2], hi[k][3]}
        o[d0] = __builtin_amdgcn_mfma_f32_32x32x16_bf16(pa0, PK(0), o[d0], 0, 0, 0);
        o[d0] = __builtin_amdgcn_mfma_f32_32x32x16_bf16(pa1, PK(1), o[d0], 0, 0, 0);
        o[d0] = __builtin_amdgcn_mfma_f32_32x32x16_bf16(pa2, PK(2), o[d0], 0, 0, 0);
        o[d0] = __builtin_amdgcn_mfma_f32_32x32x16_bf16(pa3, PK(3), o[d0], 0, 0, 0);
#undef PK
    }
}
__device__ __forceinline__ void attn_unit(int qrow0, int h, int nh, int krow0, int kvh, int NT, float m2, bf16_t* Q, const bf16_t* __restrict__ K, const bf16_t* __restrict__ V, char* shm) {
    int tid = threadIdx.x; asm volatile("" : "+v"(tid));
    const int lane = tid & 63, r32 = lane & 31, hi = lane >> 5; const int wid = __builtin_amdgcn_readfirstlane(tid >> 6);
    const bf16_t* Qw = Q + (size_t)(qrow0 + wid * QBLK) * DM + h * 64;
    const bf16_t* Kh = K + (size_t)krow0 * KP + kvh * 64; const bf16_t* Vh = V + (size_t)krow0 * KP + kvh * 64;
    const unsigned lds0 = (unsigned)(uintptr_t)shm;
    float* wsf = (float*)(shm + LDS_WS) + wid * 64;
    const int kkey = 8 * wid + (lane >> 3);
    const bf16_t* ksrc = Kh + (long)kkey * KP + (((lane & 7) ^ ((kkey >> 1) & 7)) * 8);
    const bf16_t* vsrc = Vh + (long)(16 * (wid & 3) + (lane >> 2)) * KP + (wid >> 2) * 32 + (lane & 3) * 8;
    const unsigned kdst = lds0 + LDS_K + wid * 1024, vdst = lds0 + LDS_V + wid * 1024;
#define DMA_K(t, slot) glds16(ksrc + (long)(t) * KVBLK * KP, (unsigned)__builtin_amdgcn_readfirstlane(kdst + (slot)))
#define DMA_V(t, slot) glds16(vsrc + (long)(t) * KVBLK * KP, (unsigned)__builtin_amdgcn_readfirstlane(vdst + (slot)))
    const int TT = nh * NT; int kt3 = 4 % NT, vt1 = 2 % NT;
    const unsigned qst = lds0 + LDS_QST + wid * 4096;
#define DMA_Q(hh) do { const bf16_t* qn_ = Q + (size_t)(qrow0 + wid * QBLK) * DM + (hh) * 64 + (long)r32 * DM + hi * 8; _Pragma("unroll") for (int d0 = 0; d0 < 4; ++d0) glds16(qn_ + d0 * 16, (unsigned)__builtin_amdgcn_readfirstlane(qst + d0 * 1024)); } while (0)
    const int vb0 = (int)(lds0 + LDS_V) + ((lane >> 4) & 1) * 32 + (lane & 3) * 8 + (4 * hi + ((lane & 15) >> 2)) * 64;
    const char* Kbase = shm + LDS_K; bf16x8 kf[8];
    const lds_cptr shm3 = (lds_cptr)shm; const lds_cptr kbase = shm3 + LDS_K; const int kb0 = r32 * 128 + ((hi ^ ((r32 >> 1) & 7)) * 16); const lds_cptr vp0 = shm3 + LDS_V + ((lane >> 4) & 1) * 32 + (lane & 3) * 8 + (4 * hi + ((lane & 15) >> 2)) * 64;
    DMA_K(0, 0); DMA_V(0, 0); DMA_K(1, SLOTB);
    bf16x8 qr[4];
#pragma unroll
    for (int d0 = 0; d0 < 4; ++d0) qr[d0] = *reinterpret_cast<const bf16x8*>(&Qw[(long)r32 * DM + d0 * 16 + hi * 8]);
    float l_reg = 0.f; f32x16 o[2]; o[0] = f32x16{}; o[1] = f32x16{}; f32x16 negm;
#pragma unroll
    for (int r = 0; r < 16; ++r) negm[r] = -m2;
    asm volatile("" : "+v"(negm));
    f32x16 pA0, pA1, pB0, pB1;
    int sl_prev = 0, sl_cur = 0, sl_next = SLOTB;
#define ROT() do { sl_prev = sl_cur; sl_cur = sl_next; sl_next = (sl_next == (NSLOT - 1) * SLOTB) ? 0 : sl_next + SLOTB; } while (0)
    if (nh > 1) DMA_Q(h + 1);
    DMA_K(2, 2 * SLOTB);
    WAIT_BAR(3);
    qkt(pA0, pA1, Kbase, qr, negm, r32, hi);
#pragma unroll
    for (int r = 0; r < 16; ++r) { pA0[r] = __builtin_amdgcn_exp2f(pA0[r]); pA1[r] = __builtin_amdgcn_exp2f(pA1[r]); }
    WAIT_BAR(0);
    DMA_K(3, 0); DMA_V(1, SLOTB);
    ROT();
    kload8(kf, kbase, kb0, sl_cur);
    WAIT_BAR(2);
    s16x4 vlo[8], vhi[8]; u32x4 pw0, pw1, pw2, pw3;
#define PKW(P, B) cvtpk_s(P[B], P[B + 1])
#define PAF(k) __builtin_bit_cast(bf16x8, pw##k)
#define VFR(i) (bf16x8){vlo[i][0], vlo[i][1], vlo[i][2], vlo[i][3], vhi[i][0], vhi[i][1], vhi[i][2], vhi[i][3]}
#define PIN(x) asm volatile("" : "+v"(x))
#define GAPA(MF, A0, A1, A2, A3, W0, W1, PW) do { MF; sacc += A0; sacc += A1; sacc += A2; sacc += A3; PIN(sacc); W0; W1; PIN(PW); SBAR(); } while (0)
#define EX(v) __builtin_amdgcn_exp2f(v)
#define GAPB(MF, X, B) do { MF; X[B] = EX(X[B]); X[B + 1] = EX(X[B + 1]); X[B + 2] = EX(X[B + 2]); X[B + 3] = EX(X[B + 3]); PIN(X); SBAR(); } while (0)
#define VRD(i) do { vlo[i] = vtr(vp_ + (((i) >> 2) * 4096 + ((i) & 3) * 1024)); vhi[i] = vtr(vp_ + (((i) >> 2) * 4096 + ((i) & 3) * 1024 + 512)); } while (0)
#define KRD(G, j) do { if (G) { kload2(kf, kbase, kb0, sl_next, j); SBAR(); } } while (0)
#define MF32(a, b, c) __builtin_amdgcn_mfma_f32_32x32x16_bf16(a, b, c, 0, 0, 0)
#define STEP(C0, C1, P0, P1, t, GK, GV, GL) do { SBAR(); \
    const lds_cptr vp_ = vp0 + sl_prev; \
    VRD(0); SBAR(); float sacc = (P0[0] + P0[1]); \
    GAPA(C0 = MF32(kf[0], qr[0], negm), P0[2], P0[3], P0[4], P0[5],     pw0[0] = PKW(P0, 0), pw0[1] = PKW(P0, 2), pw0); \
    VRD(4); SBAR(); GAPA(C1 = MF32(kf[1], qr[0], negm), P0[6], P0[7], P0[8], P0[9],     pw0[2] = PKW(P0, 4), pw0[3] = PKW(P0, 6), pw0); \
    VRD(1); SBAR(); GAPA(C0 = MF32(kf[2], qr[1], C0),   P0[10], P0[11], P0[12], P0[13], pw1[0] = PKW(P0, 8), pw1[1] = PKW(P0, 10), pw1); \
    VRD(5); SBAR(); GAPA(C1 = MF32(kf[3], qr[1], C1),   P0[14], P0[15], P1[0], P1[1],   pw1[2] = PKW(P0, 12), pw1[3] = PKW(P0, 14), pw1); \
    VRD(2); SBAR(); GAPA(C0 = MF32(kf[4], qr[2], C0),   P1[2], P1[3], P1[4], P1[5],     pw2[0] = PKW(P1, 0), pw2[1] = PKW(P1, 2), pw2); \
    VRD(6); SBAR(); GAPA(C1 = MF32(kf[5], qr[2], C1),   P1[6], P1[7], P1[8], P1[9],     pw2[2] = PKW(P1, 4), pw2[3] = PKW(P1, 6), pw2); \
    VRD(3); SBAR(); GAPA(C0 = MF32(kf[6], qr[3], C0),   P1[10], P1[11], P1[12], P1[13], pw3[0] = PKW(P1, 8), pw3[1] = PKW(P1, 10), pw3); \
    VRD(7); SBAR(); GAPA(C1 = MF32(kf[7], qr[3], C1),   P1[14], P1[15], 0.f, 0.f,       pw3[2] = PKW(P1, 12), pw3[3] = PKW(P1, 14), pw3); \
    l_reg += sacc; \
    if (GK) { DMA_K(kt3, sl_cur); } if (GV) { DMA_V(vt1, sl_next); } kt3 = (kt3 + 1 == NT) ? 0 : kt3 + 1; vt1 = (vt1 + 1 == NT) ? 0 : vt1 + 1; \
    SBAR(); \
    GAPB(o[0] = MF32(PAF(0), VFR(0), o[0]), C0, 0); \
    GAPB(o[1] = MF32(PAF(0), VFR(4), o[1]), C0, 4); \
    KRD(GL, 0); GAPB(o[0] = MF32(PAF(1), VFR(1), o[0]), C0, 8); \
    KRD(GL, 1); GAPB(o[1] = MF32(PAF(1), VFR(5), o[1]), C0, 12); \
    KRD(GL, 2); GAPB(o[0] = MF32(PAF(2), VFR(2), o[0]), C1, 0); \
    KRD(GL, 3); GAPB(o[1] = MF32(PAF(2), VFR(6), o[1]), C1, 4); \
    GAPB(o[0] = MF32(PAF(3), VFR(3), o[0]), C1, 8); \
    GAPB(o[1] = MF32(PAF(3), VFR(7), o[1]), C1, 12); \
    } while (0)
#define FINALIZE(hh) do { \
    { auto rr = __builtin_amdgcn_permlane32_swap(__float_as_uint(l_reg), __float_as_uint(l_reg), false, false); l_reg = __uint_as_float(rr[0]) + __uint_as_float(rr[1]); } \
    if (hi == 0) wsf[32 + r32] = l_reg; asm volatile("s_waitcnt lgkmcnt(0)" ::: "memory"); \
    float rli[16]; \
    _Pragma("unroll") for (int r = 0; r < 16; ++r) rli[r] = __builtin_amdgcn_rcpf(wsf[32 + crow(r, hi)]); \
    bf16_t* Ow = Q + (size_t)(qrow0 + wid * QBLK) * DM + (hh) * 64; \
    { bf16_t* stg = (bf16_t*)(shm + LDS_OST) + wid * 2048; \
      _Pragma("unroll") for (int r = 0; r < 16; ++r) { const int orow = crow(r, hi); \
          _Pragma("unroll") for (int d0 = 0; d0 < 2; ++d0) stg[orow * 64 + d0 * 32 + r32] = (bf16_t)f2bf(o[d0][r] * rli[r]); } \
      asm volatile("s_waitcnt lgkmcnt(0)" ::: "memory"); \
      _Pragma("unroll") for (int i = 0; i < 4; ++i) { const int row = i * 8 + (lane >> 3), ch = lane & 7; const u32x4 v = *(const u32x4*)(stg + row * 64 + ch * 8); *(u32x4*)(Ow + (long)row * DM + ch * 8) = v; } \
      asm volatile("s_waitcnt lgkmcnt(0)" ::: "memory"); } } while (0)
    int t = 1, hcur = h;
    for (int m = 0; m < nh; ++m) {
        const bool lasth = (m == nh - 1); const int lim = lasth ? TT - 5 : (m + 1) * NT - 1;
        for (; t < lim; t += 2) {
            STEP(pB0, pB1, pA0, pA1, t, true, true, true);     WAIT_BAR(2); ROT();
            STEP(pA0, pA1, pB0, pB1, t + 1, true, true, true); WAIT_BAR(2); ROT();
        }
        if (!lasth) {
            STEP(pB0, pB1, pA0, pA1, t, true, true, true);     WAIT_BAR(2); ROT();
#pragma unroll
            for (int d0 = 0; d0 < 4; ++d0) qr[d0] = *(const __attribute__((address_space(3))) bf16x8*)((lds_cptr)shm3 + LDS_QST + wid * 4096 + d0 * 1024 + lane * 16);
            STEP(pA0, pA1, pB0, pB1, t + 1, true, true, true); WAIT_BAR(2); ROT();
            FINALIZE(hcur);
            o[0] = f32x16{}; o[1] = f32x16{}; l_reg = 0.f;
            ++hcur; t += 2;
            if (hcur + 1 < h + nh) DMA_Q(hcur + 1);
        }
    }
#define ENDW(tt) do { if ((tt) + 3 < TT) { WAIT_BAR(2); } else if ((tt) + 2 < TT) { WAIT_BAR(1); } else { WAIT_BAR(0); } } while (0)
    for (; t + 1 < TT; t += 2) {
        STEP(pB0, pB1, pA0, pA1, t, (t + 3 < TT), (t + 1 < TT), (t + 1 < TT));         ENDW(t);     ROT();
        STEP(pA0, pA1, pB0, pB1, t + 1, (t + 4 < TT), (t + 2 < TT), (t + 2 < TT));     ENDW(t + 1); ROT();
    }
    STEP(pB0, pB1, pA0, pA1, TT - 1, false, false, false);
    { float sacc = pB0[0] + pB0[1];
#pragma unroll
      for (int r = 2; r < 16; ++r) sacc += pB0[r];
#pragma unroll
      for (int r = 0; r < 16; ++r) sacc += pB1[r];
      l_reg += sacc;
      pw0 = (u32x4){PKW(pB0, 0), PKW(pB0, 2), PKW(pB0, 4), PKW(pB0, 6)}; pw1 = (u32x4){PKW(pB0, 8), PKW(pB0, 10), PKW(pB0, 12), PKW(pB0, 14)}; pw2 = (u32x4){PKW(pB1, 0), PKW(pB1, 2), PKW(pB1, 4), PKW(pB1, 6)}; pw3 = (u32x4){PKW(pB1, 8), PKW(pB1, 10), PKW(pB1, 12), PKW(pB1, 14)};
      SBAR(); pv(o, vb0 + sl_cur, PAF(0), PAF(1), PAF(2), PAF(3)); }
#undef PKW
#undef PAF
#undef VFR
#undef PIN
#undef GAPA
#undef GAPB
#undef EX
#undef VRD
#undef KRD
#undef STEP
#undef ENDW
#undef MF32
    FINALIZE(hcur);
    asm volatile("s_waitcnt lgkmcnt(0)\n\ts_barrier" ::: "memory");
#undef FINALIZE
#undef DMA_K
#undef DMA_V
#undef ROT
}
#undef SBAR
#undef WAIT_BAR
}

constexpr size_t MiB = 1u << 20;
constexpr size_t WS_CTL = 0, CTL_ZERO_BYTES = 640 * 1024;
constexpr size_t WS_SFLAG = 64 * 1024, SFLAG_PHASE = 272 * 256, WS_ZERO = 32 * 1024  ;
constexpr size_t WS_MOD = 1 * MiB;
constexpr size_t WS_ROPE = 1 * MiB + 512 * 1024;
constexpr size_t WS_WQKV = 2 * MiB;
constexpr size_t WS_WO = 9 * MiB;
constexpr size_t WS_WPOOL = 14 * MiB;
constexpr size_t WS_WIN = 15 * MiB;
constexpr size_t WS_WOUT = 20 * MiB;
constexpr size_t WS_WUP = 23 * MiB;
constexpr size_t WS_WDN = 73 * MiB;
constexpr size_t WS_H = 95 * MiB;
constexpr size_t WS_BIG1 = 134 * MiB;
constexpr size_t WS_BIG2 = 230 * MiB;
constexpr size_t WS_PARTX = 302 * MiB;
constexpr size_t WS_BIASW = 303 * MiB;
constexpr size_t BW_QKV = 0, BW_WIN = 2 * 5 * 1536, BW_UP = BW_WIN + 5 * 2048;
constexpr size_t BW_CONVP = BW_UP + 4 * 5 * 5632  , BW_GAINP = BW_CONVP + 4 * 22 * 1024  , BW_END = BW_GAINP + 512;
static_assert(BW_END * 4 <= MiB, "BIASW region");
constexpr size_t WS_XB = 304 * MiB;
constexpr size_t WS_END = 343 * MiB;
constexpr size_t WS_SU = WS_BIG1, WS_SV = WS_BIG1 + 40 * MiB, WS_SPART = WS_BIG1 + 80 * MiB;
constexpr size_t WS_EDGE = WS_BIG2 + 60 * MiB;
constexpr size_t WS_Q = WS_BIG2, WS_K = WS_BIG2 + 40 * MiB, WS_V = WS_K + 10 * MiB;
static_assert((size_t)NTOK * FF * 2 <= 96 * MiB && (size_t)NTOK * RP * 2 <= 40 * MiB && WS_XB + (size_t)NTOK * RP * 2 <= WS_END && WS_H + (size_t)NTOK * RP * 2 <= WS_BIG1 && WS_WUP + (size_t)4 * FF2 * RP * 2 <= WS_WDN, "ws map");

constexpr int RING_BYTES = 131072, LDSCTL_OFF = RING_BYTES, MISC_OFF = LDSCTL_OFF + 320, XB_OFF = LDSCTL_OFF + 1024  ,
              PRM_OFF = XB_OFF + 12288  , PRM_STRIDE = 9728,
              ROPE_OFF = XB_OFF + 2048  , LDS_BYTES = PRM_OFF + 2 * PRM_STRIDE;
static_assert(LDS_BYTES <= 163840, "LDS");

#define XB_TMO      128
#define XB_XCNT(j)  (256  + 64 * (j))
#define XB_XSUB(j)  (1280 + 64 * (j))
#define XB_XGEN(j)  (2304 + 64 * (j))
#define XB_TOP      3328
#define XB_TOPGEN   3392
#define XCD_BAR_WORDS 3456
#define XB_SPIN_CAP (1u << 18)
__device__ __forceinline__ unsigned xb_ld(unsigned* p)              { return __hip_atomic_load(p, __ATOMIC_RELAXED, __HIP_MEMORY_SCOPE_AGENT); }
__device__ __forceinline__ unsigned xb_add(unsigned* p, unsigned v) { return __hip_atomic_fetch_add(p, v, __ATOMIC_RELAXED, __HIP_MEMORY_SCOPE_AGENT); }
__device__ __forceinline__ unsigned xb_xcc_id() { return (unsigned)__builtin_amdgcn_s_getreg((3 << 11) | 20) & 0xFu; }
#define XB_SPIN(cond, bar) do { unsigned _sp = 0; while (cond) { __builtin_amdgcn_s_sleep(1); \
    if ((++_sp & 255u) == 0u) { if (xb_ld(&(bar)[XB_TMO])) break; if (_sp > XB_SPIN_CAP) { atomicAdd(&(bar)[XB_TMO], 1u); break; } } } } while (0)
struct XcdBarrier { unsigned* bar; unsigned x; volatile LAS unsigned* st; };
__device__ __forceinline__ XcdBarrier xcd_barrier_post(unsigned* bar, volatile LAS unsigned* st) {
    XcdBarrier b; b.bar = bar; b.x = xb_xcc_id(); b.st = st;
    if (threadIdx.x == 0) (void)xb_add(&bar[XB_XCNT(b.x)], 1u);
    return b;
}
__device__ __forceinline__ void xcd_barrier_complete(unsigned* bar, unsigned x, unsigned& nloc, unsigned& nx) {
    const unsigned G = gridDim.x * gridDim.y * gridDim.z;
    unsigned sum, cnt, mine, sp = 0u;
    for (;;) {
        sum = 0u; cnt = 0u; mine = 0u;
#pragma unroll
        for (unsigned j = 0; j < 16; ++j) { const unsigned c = xb_ld(&bar[XB_XCNT(j)]); sum += c; cnt += (c > 0u) ? 1u : 0u; mine = (j == x) ? c : mine; }
        if (sum == G) break;
        __builtin_amdgcn_s_sleep(1);
        if ((++sp & 255u) == 0u) { if (xb_ld(&bar[XB_TMO])) break; if (sp > XB_SPIN_CAP) { atomicAdd(&bar[XB_TMO], 1u); break; } }
    }
    nloc = mine > 0u ? mine : 1u; nx = cnt > 0u ? cnt : 1u;
}
__device__ __forceinline__ void xcd_barrier(const XcdBarrier& b) {
    asm volatile("s_waitcnt vmcnt(0)" ::: "memory");
    __syncthreads();
    if (threadIdx.x == 0) {
        unsigned long long bar_u = (unsigned long long)b.bar; unsigned blo = __builtin_amdgcn_readfirstlane((unsigned)bar_u), bhi = __builtin_amdgcn_readfirstlane((unsigned)(bar_u >> 32));
        asm volatile("" : "+s"(blo), "+s"(bhi)); unsigned* bar = (unsigned*)(((unsigned long long)bhi << 32) | blo); unsigned bx = __builtin_amdgcn_readfirstlane(b.x); asm volatile("" : "+s"(bx));
        __builtin_amdgcn_s_waitcnt(0);
        unsigned nloc = b.st[0], nx = b.st[1];
        if (nloc == 0u) { xcd_barrier_complete(bar, bx, nloc, nx); b.st[0] = nloc; b.st[1] = nx; }
        const unsigned old = xb_add(&bar[XB_XSUB(bx)], 1u);
        const unsigned gen = old / nloc;
        if (old + 1u == (gen + 1u) * nloc) {
            __builtin_amdgcn_fence(__ATOMIC_RELEASE, "agent");
            asm volatile("s_waitcnt vmcnt(0)" ::: "memory");
            const unsigned og = xb_add(&bar[XB_TOP], 1u);
            const unsigned tg = og / nx;
            if (og + 1u == (tg + 1u) * nx) {
#pragma unroll
                for (unsigned j = 0; j < 16; ++j) (void)xb_add(&bar[XB_XGEN(j)], 1u);
                (void)xb_add(&bar[XB_TOPGEN], 1u);
            } else XB_SPIN(xb_ld(&bar[XB_TOPGEN]) <= tg, bar);
            __builtin_amdgcn_fence(__ATOMIC_ACQUIRE, "agent");
            asm volatile("s_waitcnt vmcnt(0)" ::: "memory");
        } else {
            XB_SPIN(xb_ld(&bar[XB_XGEN(bx)]) <= gen, bar);
            __builtin_amdgcn_fence(__ATOMIC_ACQUIRE, "agent");
            asm volatile("s_waitcnt vmcnt(0)" ::: "memory");
        }
    }
    __syncthreads();
}

struct Params { const float* in[24]; float* out; unsigned char* ws; };
enum { I_X = 0, I_C, I_CTX, I_CCTX, I_ADAW, I_ADAB, I_NORMW, I_WQKV, I_QG, I_KG, I_WO, I_POOLW, I_POOLB, I_POOLS, I_SWIN, I_SVG, I_SWS, I_SBS, I_SWOUT, I_WUP, I_CONVW, I_CONVB, I_WDN, I_FNORM };

struct Frame {
    unsigned char* ws; float* X;
    LAS unsigned char* lds3;
    float* lds;
};
__device__ __forceinline__ const float* inp(const Params& p, int k) { asm volatile("" : "+s"(k)); return p.in[k]; }
#define IN(k) inp(p, (k))
#define PHASE_IDS int tid = threadIdx.x; asm volatile("" : "+v"(tid)); const int lane = tid & 63, wave = __builtin_amdgcn_readfirstlane(tid >> 6); int bid = blockIdx.x; asm volatile("" : "+s"(bid)); const int G = gridDim.x; (void)lane; (void)wave; (void)bid; (void)G;
__device__ __forceinline__ unsigned char* wsp(unsigned char* ws, unsigned off) { asm volatile("" : "+s"(off)); return ws + off; }
#define WSP(T, off) ((T*)wsp(F.ws, (unsigned)(off)))

__device__ __forceinline__ float wave_sum(float v) {
#pragma unroll
    for (int o = 32; o > 0; o >>= 1) v += __shfl_xor(v, o);
    return v;
}
__device__ __forceinline__ int vidx(int r) { return r < NLAT ? r / L : 4; }
__device__ __forceinline__ float silu_f(float x) { return x / (1.f + expf(-x)); }


__device__ __forceinline__ void dma1k(const void* src, LAS unsigned char* dst, int lane) {
    __builtin_amdgcn_global_load_lds((const unsigned*)((const char*)src + lane * 16), (LAS unsigned*)dst, 16, 0, 0);
}
__device__ __forceinline__ void epi_sync() { asm volatile("s_waitcnt vmcnt(0) lgkmcnt(0)" ::: "memory"); __builtin_amdgcn_s_barrier(); asm volatile("" ::: "memory"); }
__device__ __forceinline__ void row_rs(const LAS float* prm, int rl_base, float (&rs)[2][4]) {
#pragma unroll
    for (int ai = 0; ai < 2; ++ai)
#pragma unroll
        for (int m = 0; m < 4; ++m) { const f32x4 q = *(const LAS f32x4*)(prm + (rl_base + ai * 128 + m * 16) * 4); rs[ai][m] = rsqrtf(((q[0] + q[1]) + (q[2] + q[3])) * (1.f / D) + EPS); }
}
template <bool POOL, bool FINM = false>
struct EpiResid {
    static __host__ __device__ __forceinline__ int brow(int R) { const int rho = R & 31, n = rho >> 4, i = rho & 15; return (R & ~31) + 8 * (i >> 2) + 4 * n + (i & 3); }
    bf16_t* X  ; const float* mod_layer; int part; const float* bias; const float* scale;
    bf16_t* Hn; float* PARTX; const float* nwn; const float* modn; int partn; LAS float* sred  ; LAS float* prm;
    static constexpr int FIN_TAG = 99;
    __device__ __forceinline__ void prefetch(const pg8::Unit& u, int wid, int lane, int pbuf) const {
        const int rt = u.pm * 256, v = rt >= NLAT ? 4 : rt / L; const unsigned c = u.pn * 256; LAS unsigned char* pb = (LAS unsigned char*)prm + pbuf * PRM_STRIDE;
        if (wid == 0) dma1k(mod_layer + ((size_t)v * 6 + part) * D + c, pb, lane);
        if (Hn != nullptr) { if (wid == 1) dma1k(nwn + c, pb + 1024, lane); if (wid == 2) dma1k(modn + ((size_t)v * 6 + partn) * D + c, pb + 2048, lane); }
        if (POOL) { if (wid == 3) dma1k(scale + c, pb + 3072, lane); if (wid == 4) dma1k(bias + c, pb + 4096, lane); }
    }
    __device__ __forceinline__ void operator()(const f32x4 (&acc)[2][2][4][2], const pg8::Unit& u, int wr, int wc, int fr, int fq, int pbuf) const {
        const LAS float* prm = this->prm + pbuf * (PRM_STRIDE / 4);
        const int rt = u.pm * 256; const bool isctx = rt >= NLAT; const int v = isctx ? 4 : rt / L;
        const bf16_t* src = X + (size_t)rt * RP; bf16_t* dst = X + (size_t)rt * RP;
        const int tid = (wr * 4 + wc) * 64 + fq * 16 + fr;
        const bool next = Hn != nullptr, fin = FINM && !next && partn == FIN_TAG, need_ss = next || fin;
        const int colu = wc * 32 + 8 * fq, col0 = u.pn * 256 + colu;
#define RES_LOAD(XV, g_) do { const int c_ = col0 + ((g_) >> 1) * 128; _Pragma("unroll") for (int m = 0; m < 4; ++m) \
            XV[m] = *(const u32x4*)(src + (unsigned)((wr * 64 + fr + ((g_) & 1) * 128 + m * 16) * RP + c_)); } while (0)
        u32x4 xA[4], xB[4];
        RES_LOAD(xA, 0); RES_LOAD(xB, 1);
        float ss[2][4];
#pragma unroll
        for (int ai = 0; ai < 2; ++ai)
#pragma unroll
            for (int m = 0; m < 4; ++m) ss[ai][m] = 0.f;
#define RES_PROC(XV, g_) do { constexpr int bj_ = (g_) >> 1, ai = (g_) & 1; const int cu = colu + bj_ * 128, c = col0 + bj_ * 128; \
            f32x4 gv0 = *(const LAS f32x4*)(prm + cu), gv1 = *(const LAS f32x4*)(prm + cu + 4), ga0, ga1, gn0, gn1; \
            if (POOL) { gv0 = gv0 * *(const LAS f32x4*)(prm + 768 + cu); gv1 = gv1 * *(const LAS f32x4*)(prm + 768 + cu + 4); ga0 = gv0 * *(const LAS f32x4*)(prm + 1024 + cu); ga1 = gv1 * *(const LAS f32x4*)(prm + 1024 + cu + 4); } \
            if (next) { gn0 = *(const LAS f32x4*)(prm + 256 + cu) * (*(const LAS f32x4*)(prm + 512 + cu) + 1.f); gn1 = *(const LAS f32x4*)(prm + 256 + cu + 4) * (*(const LAS f32x4*)(prm + 512 + cu + 4) + 1.f); } \
            _Pragma("unroll") for (int m = 0; m < 4; ++m) { const int rl = wr * 64 + fr + ai * 128 + m * 16; const unsigned off = (unsigned)rl * RP + c; \
                const u32x4 xw_ = XV[m]; const f32x4 xo0 = unpkh4((u32x2){xw_.x, xw_.y}), xo1 = unpkh4((u32x2){xw_.z, xw_.w}); \
                f32x4 xn0 = xo0 + gv0 * acc[ai][bj_][m][0], xn1 = xo1 + gv1 * acc[ai][bj_][m][1]; if (POOL) { xn0 = xn0 + ga0; xn1 = xn1 + ga1; } \
                { u32x4 xw; xw.x = pkh2(xn0[0], xn0[1]); xw.y = pkh2(xn0[2], xn0[3]); xw.z = pkh2(xn1[0], xn1[1]); xw.w = pkh2(xn1[2], xn1[3]); *(u32x4*)(dst + off) = xw; } \
                if (need_ss) ss[ai][m] += ((xn0[0] * xn0[0] + xn0[1] * xn0[1]) + (xn0[2] * xn0[2] + xn0[3] * xn0[3])) + ((xn1[0] * xn1[0] + xn1[1] * xn1[1]) + (xn1[2] * xn1[2] + xn1[3] * xn1[3])); \
                if (next) { const f32x4 hv0 = xn0 * gn0, hv1 = xn1 * gn1; \
                    u32x4 w; w.x = pk2(hv0[0], hv0[1]); w.y = pk2(hv0[2], hv0[3]); w.z = pk2(hv1[0], hv1[1]); w.w = pk2(hv1[2], hv1[3]); *(u32x4*)(Hn + (unsigned)(rt + rl) * RP + c) = w; } } } while (0)
        RES_PROC(xA, 0); asm volatile("" ::: "memory");
        RES_LOAD(xA, 2); asm volatile("" ::: "memory");
        RES_PROC(xB, 1); asm volatile("" ::: "memory");
        RES_LOAD(xB, 3); asm volatile("" ::: "memory");
        RES_PROC(xA, 2); asm volatile("" ::: "memory");
        RES_PROC(xB, 3);
#undef RES_LOAD
#undef RES_PROC
        if (need_ss) {
#pragma unroll
            for (int ai = 0; ai < 2; ++ai)
#pragma unroll
                for (int m = 0; m < 4; ++m) { float t = ss[ai][m]; t += __shfl_xor(t, 16); t += __shfl_xor(t, 32);
                    if (fq == 0) sred[(wr * 64 + fr + ai * 128 + m * 16) * 4 + wc] = t; }
            asm volatile("s_waitcnt lgkmcnt(0)" ::: "memory"); __builtin_amdgcn_s_barrier(); asm volatile("" ::: "memory");
            if (tid < 256) { const f32x4 q = *(const LAS f32x4*)(sred + tid * 4); const float t = (q[0] + q[1]) + (q[2] + q[3]);
                if (!fin) PARTX[(unsigned)(rt + tid) * 4u + u.pn] = t;
                else { const __amdgpu_buffer_rsrc_t prs = __builtin_amdgcn_make_buffer_rsrc((void*)PARTX, 0, 0x7fffffff, 0x00020000);
                       __builtin_amdgcn_raw_buffer_store_b32(__builtin_bit_cast(unsigned, t), prs, ((unsigned)(rt + tid) * 4u + u.pn) * 4u, 0, 16  ); } }
        }
    }
};


template <class Epi> struct EpiTailT {
    static __host__ __device__ __forceinline__ int brow(int R) { return Epi::brow(R); }
    __device__ __forceinline__ void prefetch(const pg8::Unit&, int, int, int) const {}
    float* slab; unsigned* flags;
    __device__ __forceinline__ void operator()(const f32x4 (&acc)[2][2][4][2], const pg8::Unit& u, int wr, int wc, int fr, int fq, int pbuf) const {
        const int tid = (wr * 4 + wc) * 64 + fq * 16 + fr; const unsigned ui = u.rng;
        const __amdgpu_buffer_rsrc_t rsrc = __builtin_amdgcn_make_buffer_rsrc((void*)slab, 0, 0x7fffffff, 0x00020000);
        const unsigned voff = ui * 131072u + (unsigned)tid * 16u;
#pragma unroll
        for (int ai = 0; ai < 2; ++ai)
#pragma unroll
            for (int bj = 0; bj < 2; ++bj)
#pragma unroll
                for (int m = 0; m < 4; ++m) { const f32x4 a = acc[ai][bj][m][0], b = acc[ai][bj][m][1];
                    u32x4 w; w.x = pkh2(a[0], a[1]); w.y = pkh2(a[2], a[3]); w.z = pkh2(b[0], b[1]); w.w = pkh2(b[2], b[3]);
                    __builtin_amdgcn_raw_buffer_store_b128(w, rsrc, voff, ((ai * 2 + bj) * 4 + m) * 8192, 16  ); }
        asm volatile("s_waitcnt vmcnt(0)" ::: "memory"); __builtin_amdgcn_s_barrier(); asm volatile("" ::: "memory");
        if (tid == 0) __hip_atomic_store(flags + ui * 64, 1u, __ATOMIC_RELAXED, __HIP_MEMORY_SCOPE_AGENT);
    }
};
template <class Epi> struct EpiHead {
    static __host__ __device__ __forceinline__ int brow(int R) { return Epi::brow(R); }
    __device__ __forceinline__ void prefetch(const pg8::Unit& u, int wid, int lane, int pbuf) const { E.prefetch(u, wid, lane, pbuf); }
    Epi E; const float* slab; unsigned* flags; LAS unsigned char* lds3  ;
    __device__ __forceinline__ void operator()(f32x4 (&acc)[2][2][4][2], const pg8::Unit& u, int wr, int wc, int fr, int fq, int pbuf) const {
        const int tid = (wr * 4 + wc) * 64 + fq * 16 + fr; const unsigned ui = u.rng + 1;
        const bool head = u.role == 2;
        if (head) {
            if (tid == 0) { unsigned sp = 0;
                while (__hip_atomic_load(flags + ui * 64, __ATOMIC_RELAXED, __HIP_MEMORY_SCOPE_AGENT) == 0u) { __builtin_amdgcn_s_sleep(2); if (++sp > (1u << 22)) break; }
                __builtin_amdgcn_fence(__ATOMIC_ACQUIRE, "agent"); asm volatile("s_waitcnt vmcnt(0)" ::: "memory"); }
            asm volatile("s_waitcnt vmcnt(0) lgkmcnt(0)" ::: "memory"); __builtin_amdgcn_s_barrier(); asm volatile("" ::: "memory");
            const int w8 = wr * 4 + wc; const char* sp = (const char*)slab + (size_t)ui * 131072u + w8 * 1024;
#pragma unroll
            for (int g = 0; g < 16; ++g) dma1k(sp + g * 8192, lds3 + g * 8192 + w8 * 1024, (fq << 4) | fr);
            asm volatile("s_waitcnt vmcnt(0)" ::: "memory");
        }
        const unsigned lbase = head ? (unsigned)tid * 16u : (unsigned)XB_OFF; const int gmul = head ? 8192 : 0;
#pragma unroll
        for (int ai = 0; ai < 2; ++ai)
#pragma unroll
            for (int bj = 0; bj < 2; ++bj)
#pragma unroll
                for (int m = 0; m < 4; ++m) { const u32x4 t = *(const LAS u32x4*)(lds3 + lbase + ((ai * 2 + bj) * 4 + m) * gmul);
                    u32x2 lo, hi; lo.x = t.x; lo.y = t.y; hi.x = t.z; hi.y = t.w;
                    acc[ai][bj][m][0] = acc[ai][bj][m][0] + unpkh4(lo); acc[ai][bj][m][1] = acc[ai][bj][m][1] + unpkh4(hi);
                    asm volatile("" : "+v"(acc[ai][bj][m][0]), "+v"(acc[ai][bj][m][1]) :: "memory"); }
        asm volatile("s_waitcnt lgkmcnt(0)" ::: "memory");
        E(acc, u, wr, wc, fr, fq, pbuf);
    }
};

struct EpiQKV {
    static __host__ __device__ __forceinline__ int brow(int R) { const int wc = R >> 5, n = (R >> 4) & 1, i = R & 15, fq = i >> 2, reg = i & 3; return 64 * wc + 32 * (fq >> 1) + 8 * (fq & 1) + 4 * n + reg; }
    bf16_t* Q; bf16_t* K; size_t kv_stride  ; const float* gainp  ; const float* PARTX; const float* bw  ; LAS float* prm; const LAS float* rope;
    __device__ __forceinline__ void prefetch(const pg8::Unit& u, int wid, int lane, int pbuf) const {
        const int rt = u.pm * 256; LAS unsigned char* pb = (LAS unsigned char*)prm + pbuf * PRM_STRIDE;
        if (wid < 4) dma1k(PARTX + (size_t)rt * 4 + wid * 256, pb + wid * 1024, lane);
        if (wid == 4) dma1k(bw + (size_t)(rt >= NLAT ? 4 : rt / L) * QKVW + u.pn * 256, pb + 4096, lane);
        if (wid == 5) dma1k(gainp, pb + 5120, lane);
    }
    __device__ __forceinline__ void operator()(f32x4 (&acc)[2][2][4][2], const pg8::Unit& u, int wr, int wc, int fr, int fq, int pbuf) const {
        const LAS float* prm = this->prm + pbuf * (PRM_STRIDE / 4);
        const int rt = u.pm * 256; const bool isctx = rt >= NLAT; const int type = u.pn < 4 ? 0 : u.pn - 3;
        const int dimbase = 32 * (fq >> 1) + 8 * (fq & 1);
        const int tid = (wr * 4 + wc) * 64 + fq * 16 + fr;
        { float rsx[2][4]; row_rs(prm, wr * 64 + fr, rsx);
#pragma unroll
          for (int bj = 0; bj < 2; ++bj)
#pragma unroll
              for (int n = 0; n < 2; ++n) { const f32x4 bwv = *(const LAS f32x4*)(prm + 1024 + wc * 64 + dimbase + 16 * bj + 4 * n);
#pragma unroll
                  for (int ai = 0; ai < 2; ++ai)
#pragma unroll
                      for (int m = 0; m < 4; ++m) acc[ai][bj][m][n] = acc[ai][bj][m][n] * rsx[ai][m] + bwv; } }
        const LAS float* gp = prm + (type == 0 ? 1280 : 1344) + dimbase;
        const float osc = type == 0 ? attn_body::C2 : 1.f;
#pragma unroll
        for (int ai = 0; ai < 2; ++ai)
#pragma unroll
            for (int m = 0; m < 4; ++m) {
                const int r = rt + wr * 64 + fr + ai * 128 + m * 16;
                f32x4 y[2][2];
#pragma unroll
                for (int bj = 0; bj < 2; ++bj)
#pragma unroll
                    for (int n = 0; n < 2; ++n) y[bj][n] = acc[ai][bj][m][n];
                if (type < 2) {
                    float ss = 0.f;
#pragma unroll
                    for (int bj = 0; bj < 2; ++bj)
#pragma unroll
                        for (int n = 0; n < 2; ++n) { const f32x4 a = y[bj][n]; ss += (a[0] * a[0] + a[1] * a[1]) + (a[2] * a[2] + a[3] * a[3]); }
                    ss += __shfl_xor(ss, 16); ss += __shfl_xor(ss, 32);
                    const float rs = rsqrtf(ss * (1.f / HD) + EPS) * osc;
#pragma unroll
                    for (int bj = 0; bj < 2; ++bj)
#pragma unroll
                        for (int n = 0; n < 2; ++n) y[bj][n] = y[bj][n] * rs * *(const LAS f32x4*)(gp + 16 * bj + 4 * n);
                    if (!isctx) {
                        const int t = r & (L - 1); const int pos = (fq >> 1) ? (t & 63) : (t >> 6);
#pragma unroll
                        for (int n = 0; n < 2; ++n) {
                            const f32x4 cs = *(const LAS f32x4*)(rope + pos * 16 + 8 * (fq & 1) + 4 * n), sn = *(const LAS f32x4*)(rope + 1024 + pos * 16 + 8 * (fq & 1) + 4 * n);
                            const f32x4 a = y[0][n], b = y[1][n];
                            y[0][n] = a * cs - b * sn; y[1][n] = b * cs + a * sn;
                        }
                    }
                }
                bf16_t* dst;
                if (type == 0) dst = Q + (unsigned)(r * RP + (4 * u.pn + wc) * 64);
                else { const int kvrow = isctx ? ((r - NLAT) >> 8) * (LC + L) + ((r - NLAT) & (LC - 1)) : (r >> 12) * (LC + L) + LC + (r & (L - 1));
                       dst = K + (size_t)(type - 1) * kv_stride + (unsigned)(kvrow * 256 + wc * 64); }
                u32x4 w0, w1;
                w0.x = pk2(y[0][0][0], y[0][0][1]); w0.y = pk2(y[0][0][2], y[0][0][3]); w0.z = pk2(y[0][1][0], y[0][1][1]); w0.w = pk2(y[0][1][2], y[0][1][3]);
                w1.x = pk2(y[1][0][0], y[1][0][1]); w1.y = pk2(y[1][0][2], y[1][0][3]); w1.z = pk2(y[1][1][0], y[1][1][1]); w1.w = pk2(y[1][1][2], y[1][1][3]);
#pragma unroll
                for (int e = 0; e < 4; ++e) { auto sw = __builtin_amdgcn_permlane32_swap(w0[e], w1[e], false, false); w0[e] = sw[0]; w1[e] = sw[1]; }
                *(u32x4*)(dst + 8 * fq) = w0; *(u32x4*)(dst + 32 + 8 * fq) = w1;
            }
    }
};

template <int CTRL> __device__ __forceinline__ float dppf(float oldv, float src) { return __builtin_bit_cast(float, __builtin_amdgcn_update_dpp(__builtin_bit_cast(int, oldv), __builtin_bit_cast(int, src), CTRL, 0xf, 0xf, false)); }
template <int CTRL> __device__ __forceinline__ float dppz(float src) { return __builtin_bit_cast(float, __builtin_amdgcn_update_dpp(0, __builtin_bit_cast(int, src), CTRL, 0xf, 0xf, true)); }
template <int CTRL> __device__ __forceinline__ f32x4 dpp4(f32x4 oldv, f32x4 src) { f32x4 r; r[0] = dppf<CTRL>(oldv[0], src[0]); r[1] = dppf<CTRL>(oldv[1], src[1]); r[2] = dppf<CTRL>(oldv[2], src[2]); r[3] = dppf<CTRL>(oldv[3], src[3]); return r; }
__device__ __forceinline__ float silu_fast(float g) { return g * __builtin_amdgcn_rcpf(1.f + __builtin_amdgcn_exp2f(-1.4426950408889634f * g)); }
__device__ __forceinline__ void conv_in(f32x4& r, const f32x4& x, const f32x4& w0, const f32x4& w2) {
    float r0 = r[0], r1 = r[1], r2 = r[2], r3 = r[3];
    asm volatile("s_nop 1\n\t"
                 "v_fmac_f32_dpp %0, %4, %8 row_shr:1 row_mask:0xf bank_mask:0xf bound_ctrl:0\n\t"
                 "v_fmac_f32_dpp %1, %5, %9 row_shr:1 row_mask:0xf bank_mask:0xf bound_ctrl:0\n\t"
                 "v_fmac_f32_dpp %2, %6, %10 row_shr:1 row_mask:0xf bank_mask:0xf bound_ctrl:0\n\t"
                 "v_fmac_f32_dpp %3, %7, %11 row_shr:1 row_mask:0xf bank_mask:0xf bound_ctrl:0\n\t"
                 "v_fmac_f32_dpp %0, %4, %12 row_shl:1 row_mask:0xf bank_mask:0xf bound_ctrl:0\n\t"
                 "v_fmac_f32_dpp %1, %5, %13 row_shl:1 row_mask:0xf bank_mask:0xf bound_ctrl:0\n\t"
                 "v_fmac_f32_dpp %2, %6, %14 row_shl:1 row_mask:0xf bank_mask:0xf bound_ctrl:0\n\t"
                 "v_fmac_f32_dpp %3, %7, %15 row_shl:1 row_mask:0xf bank_mask:0xf bound_ctrl:0"
                 : "+v"(r0), "+v"(r1), "+v"(r2), "+v"(r3)
                 : "v"(x[0]), "v"(x[1]), "v"(x[2]), "v"(x[3]), "v"(w0[0]), "v"(w0[1]), "v"(w0[2]), "v"(w0[3]), "v"(w2[0]), "v"(w2[1]), "v"(w2[2]), "v"(w2[3]));
    r = (f32x4){r0, r1, r2, r3};
}
template <bool PREV> __device__ __forceinline__ void conv_edge(f32x4& r, const f32x4& x, const f32x4& we) {
    float r0 = r[0], r1 = r[1], r2 = r[2], r3 = r[3];
    if (PREV) asm volatile("s_nop 1\n\t"
                 "v_fmac_f32_dpp %0, %4, %8 row_ror:1 row_mask:0xf bank_mask:0xf\n\t"
                 "v_fmac_f32_dpp %1, %5, %9 row_ror:1 row_mask:0xf bank_mask:0xf\n\t"
                 "v_fmac_f32_dpp %2, %6, %10 row_ror:1 row_mask:0xf bank_mask:0xf\n\t"
                 "v_fmac_f32_dpp %3, %7, %11 row_ror:1 row_mask:0xf bank_mask:0xf"
                 : "+v"(r0), "+v"(r1), "+v"(r2), "+v"(r3) : "v"(x[0]), "v"(x[1]), "v"(x[2]), "v"(x[3]), "v"(we[0]), "v"(we[1]), "v"(we[2]), "v"(we[3]));
    else asm volatile("s_nop 1\n\t"
                 "v_fmac_f32_dpp %0, %4, %8 row_ror:15 row_mask:0xf bank_mask:0xf\n\t"
                 "v_fmac_f32_dpp %1, %5, %9 row_ror:15 row_mask:0xf bank_mask:0xf\n\t"
                 "v_fmac_f32_dpp %2, %6, %10 row_ror:15 row_mask:0xf bank_mask:0xf\n\t"
                 "v_fmac_f32_dpp %3, %7, %11 row_ror:15 row_mask:0xf bank_mask:0xf"
                 : "+v"(r0), "+v"(r1), "+v"(r2), "+v"(r3) : "v"(x[0]), "v"(x[1]), "v"(x[2]), "v"(x[3]), "v"(we[0]), "v"(we[1]), "v"(we[2]), "v"(we[3]));
    r = (f32x4){r0, r1, r2, r3};
}
struct EpiUpConv {
    static __host__ __device__ __forceinline__ int brow(int R) { const int rho = R & 31, n = rho >> 4, i = rho & 15; return (R & ~31) + 8 * (i >> 2) + 4 * n + (i & 3); }
    bf16_t* G; float* EDGE; const float* convp  ; LAS float* xb; const float* PARTX; const float* bwp  ; LAS float* prm;
    __device__ __forceinline__ void prefetch(const pg8::Unit& u, int wid, int lane, int pbuf) const {
        const int rt = u.pm * 256; LAS unsigned char* pb = (LAS unsigned char*)prm + pbuf * PRM_STRIDE;
        if (wid < 4) { dma1k(PARTX + (size_t)rt * 4 + wid * 256, pb + wid * 1024, lane); dma1k(convp + (size_t)u.pn * 1024 + wid * 256, pb + 5120 + wid * 1024, lane); }
        if (wid == 4) dma1k(bwp + ((size_t)(rt >= NLAT ? 4 : rt / L) * 22 + u.pn) * 256, pb + 4096, lane);
    }
    __device__ __forceinline__ void operator()(f32x4 (&acc)[2][2][4][2], const pg8::Unit& u, int wr, int wc, int fr, int fq, int pbuf) const {
        const LAS float* prm = this->prm + pbuf * (PRM_STRIDE / 4);
        constexpr int DPP_SHR1 = 0x111, DPP_SHL1 = 0x101, DPP_ROR1 = 0x121, DPP_ROL1 = 0x12F;
        const int colw = 32 * wc + 8 * fq, f0 = 128 * u.pn, rt = u.pm * 256;
        const int tid = (wr * 4 + wc) * 64 + fq * 16 + fr;
        { float rsx[2][4]; row_rs(prm, wr * 64 + fr, rsx);
#pragma unroll
          for (int bj = 0; bj < 2; ++bj)
#pragma unroll
              for (int n = 0; n < 2; ++n) { const f32x4 bwv = *(const LAS f32x4*)(prm + 1024 + bj * 128 + colw + 4 * n);
#pragma unroll
                  for (int ai = 0; ai < 2; ++ai)
#pragma unroll
                      for (int m = 0; m < 4; ++m) acc[ai][bj][m][n] = acc[ai][bj][m][n] * rsx[ai][m] + bwv; } }
#pragma unroll
        for (int ai = 0; ai < 2; ++ai) { const int q = 2 * ai + wr;
#pragma unroll
            for (int bj = 0; bj < 2; ++bj)
#pragma unroll
                for (int n = 0; n < 2; ++n) {
                    if (fr == 0) *(LAS f32x4*)(xb + (((q + 1) * 2 + 0) * 2 + bj) * 128 + colw + 4 * n) = acc[ai][bj][0][n];
                    if (fr == 15) *(LAS f32x4*)(xb + (((q + 1) * 2 + 1) * 2 + bj) * 128 + colw + 4 * n) = acc[ai][bj][3][n];
                } }
        if (wr == 0 && fr < 2) {
#pragma unroll
            for (int bj = 0; bj < 2; ++bj)
#pragma unroll
                for (int n = 0; n < 2; ++n) *(f32x4*)(EDGE + (unsigned)((u.pm * 4 + fr) * FF2 + bj * FF + f0 + colw + 4 * n)) = acc[0][bj][0][n]; }
        if (wr == 1 && fr >= 14) {
#pragma unroll
            for (int bj = 0; bj < 2; ++bj)
#pragma unroll
                for (int n = 0; n < 2; ++n) *(f32x4*)(EDGE + (unsigned)((u.pm * 4 + (fr - 12)) * FF2 + bj * FF + f0 + colw + 4 * n)) = acc[1][bj][3][n]; }
        asm volatile("s_waitcnt lgkmcnt(0)" ::: "memory"); __builtin_amdgcn_s_barrier(); asm volatile("" ::: "memory");
        const float m0 = fr == 0 ? 1.f : 0.f, m15 = fr == 15 ? 1.f : 0.f;
#pragma unroll
        for (int bj = 0; bj < 2; ++bj)
#pragma unroll
            for (int n = 0; n < 2; ++n) {
                const LAS float* pp = prm + 1024 + bj * 128 + colw + 4 * n;
                const f32x4 w0 = *(const LAS f32x4*)(pp + 256), w1 = *(const LAS f32x4*)(pp + 512), w2 = *(const LAS f32x4*)(pp + 768), bb = *(const LAS f32x4*)(pp + 1024);
                const f32x4 w0e = w0 * m0, w2e = w2 * m15;
#pragma unroll
                for (int ai = 0; ai < 2; ++ai) { const int q = 2 * ai + wr;
                    const f32x4 lo = *(const LAS f32x4*)(xb + ((q * 2 + 1) * 2 + bj) * 128 + colw + 4 * n);
                    const f32x4 hi = *(const LAS f32x4*)(xb + (((q + 2) * 2 + 0) * 2 + bj) * 128 + colw + 4 * n);
                    f32x4 saved = lo;
#pragma unroll
                    for (int m = 0; m < 4; ++m) {
                        const f32x4 cur = acc[ai][bj][m][n];
                        f32x4 r = w1 * cur + bb;
                        if (m == 0) r = r + lo * w0e; else conv_edge<true>(r, saved, w0e);
                        if (m == 3) r = r + hi * w2e; else conv_edge<false>(r, acc[ai][bj][m + 1][n], w2e);
                        conv_in(r, cur, w0, w2);
                        acc[ai][bj][m][n] = r;
                        saved = cur;
                    } }
            }
#pragma unroll
        for (int ai = 0; ai < 2; ++ai)
#pragma unroll
            for (int m = 0; m < 4; ++m) {
                const int r = rt + ai * 128 + wr * 64 + m * 16 + fr;
                float o[8];
#pragma unroll
                for (int n = 0; n < 2; ++n)
#pragma unroll
                    for (int e = 0; e < 4; ++e) { const float gp = acc[ai][1][m][n][e]; o[4 * n + e] = (gp * acc[ai][0][m][n][e]) * __builtin_amdgcn_rcpf(1.f + __builtin_amdgcn_exp2f(gp)); }
                u32x4 w; w.x = pk2(o[0], o[1]); w.y = pk2(o[2], o[3]); w.z = pk2(o[4], o[5]); w.w = pk2(o[6], o[7]);
                *(u32x4*)(G + (unsigned)(r * FF + f0 + colw)) = w;
            }
    }
};
__device__ __forceinline__ void ffn_fixup(const Frame& F, const float* cw, const float* cb, const float* EDGE, bf16_t* Gout) {
    PHASE_IDS
    const int total = 60 * 2 * (FF / 4);
    for (int i = bid * NT + tid; i < total; i += G * NT) {
        const int f = (i % (FF / 4)) * 4, which = (i / (FF / 4)) & 1, bd = i / (2 * (FF / 4));
        const int pmA = (bd / 15) * 16 + bd % 15, pmB = pmA + 1;
        const float* um = which == 0 ? EDGE + ((size_t)pmA * 4 + 2) * FF2 : EDGE + ((size_t)pmA * 4 + 3) * FF2;
        const float* uc = which == 0 ? EDGE + ((size_t)pmA * 4 + 3) * FF2 : EDGE + ((size_t)pmB * 4 + 0) * FF2;
        const float* up = which == 0 ? EDGE + ((size_t)pmB * 4 + 0) * FF2 : EDGE + ((size_t)pmB * 4 + 1) * FF2;
        const int r = pmB * 256 - 1 + which;
        f32x4 a[2];
#pragma unroll
        for (int part = 0; part < 2; ++part) { const int col = part * FF + f;
            a[part] = *(const f32x4*)(cw + col) * *(const f32x4*)(um + col) + *(const f32x4*)(cw + FF2 + col) * *(const f32x4*)(uc + col) + *(const f32x4*)(cw + 2 * FF2 + col) * *(const f32x4*)(up + col) + *(const f32x4*)(cb + col); }
        u32x2 w; w.x = pk2(silu_fast(a[1][0]) * a[0][0], silu_fast(a[1][1]) * a[0][1]); w.y = pk2(silu_fast(a[1][2]) * a[0][2], silu_fast(a[1][3]) * a[0][3]);
        *(u32x2*)(Gout + (size_t)r * FF + f) = w;
    }
}


__device__ __forceinline__ float gelu_fast(float x) { const float u = x * __builtin_fmaf(x * x, -2.885390081777927f * 0.7978845608028654f * 0.044715f, -2.885390081777927f * 0.7978845608028654f); return x * __builtin_amdgcn_rcpf(1.f + __builtin_amdgcn_exp2f(u)); }
struct EpiGelu {
    static __host__ __device__ __forceinline__ int brow(int R) { const int rho = R & 31, n = rho >> 4, i = rho & 15; return (R & ~31) + 8 * (i >> 2) + 4 * n + (i & 3); }
    bf16_t* U; bf16_t* V; float* PART; const float* PARTX; const float* bw  ; LAS float* prm;
    __device__ __forceinline__ void prefetch(const pg8::Unit& u, int wid, int lane, int pbuf) const {
        const int rt = u.pm * 256; LAS unsigned char* pb = (LAS unsigned char*)prm + pbuf * PRM_STRIDE;
        if (wid < 4) dma1k(PARTX + (size_t)rt * 4 + wid * 256, pb + wid * 1024, lane);
        if (wid == 4) dma1k(bw + (size_t)(rt >= NLAT ? 4 : rt / L) * 2048 + u.pn * 256, pb + 4096, lane);
    }
    __device__ __forceinline__ void operator()(f32x4 (&acc)[2][2][4][2], const pg8::Unit& u, int wr, int wc, int fr, int fq, int pbuf) const {
        const LAS float* prm = this->prm + pbuf * (PRM_STRIDE / 4);
        const bool isv = u.pn >= 4; bf16_t* dstb = isv ? V : U; const int colt = (u.pn & 3) * 256 + wc * 32 + 8 * fq;
        const int rt = u.pm * 256, tid = (wr * 4 + wc) * 64 + fq * 16 + fr;
        { float rsx[2][4]; row_rs(prm, wr * 64 + fr, rsx);
#pragma unroll
          for (int bj = 0; bj < 2; ++bj)
#pragma unroll
              for (int n = 0; n < 2; ++n) { const f32x4 bwv = *(const LAS f32x4*)(prm + 1024 + 128 * bj + wc * 32 + 8 * fq + 4 * n);
#pragma unroll
                  for (int ai = 0; ai < 2; ++ai)
#pragma unroll
                      for (int m = 0; m < 4; ++m) acc[ai][bj][m][n] = acc[ai][bj][m][n] * rsx[ai][m] + bwv; } }
#pragma unroll
        for (int ai = 0; ai < 2; ++ai)
#pragma unroll
            for (int m = 0; m < 4; ++m) { const int r = rt + wr * 64 + fr + ai * 128 + m * 16; float ss = 0.f;
#pragma unroll
                for (int bj = 0; bj < 2; ++bj) { float z[8];
#pragma unroll
                    for (int n = 0; n < 2; ++n)
#pragma unroll
                        for (int e = 0; e < 4; ++e) { z[4 * n + e] = gelu_fast(acc[ai][bj][m][n][e]); ss += z[4 * n + e] * z[4 * n + e]; }
                    u32x4 w; w.x = pk2(z[0], z[1]); w.y = pk2(z[2], z[3]); w.z = pk2(z[4], z[5]); w.w = pk2(z[6], z[7]);
                    *(u32x4*)(dstb + (unsigned)(r * RP + colt + bj * 128)) = w; }
                if (isv) { ss += __shfl_xor(ss, 16); ss += __shfl_xor(ss, 32); if (fq == 0) PART[(unsigned)(r * 16 + (u.pn - 4) * 4 + wc)] = ss; }
            }
    }
};
__device__ __forceinline__ void sgu_spatial(const Frame& F, const float* w_s, const float* b_s, const float* vg, const bf16_t* U, const bf16_t* V, const float* PART, bf16_t* Og, int nrows) {
    PHASE_IDS
    typedef short v4i16_t __attribute__((ext_vector_type(4)));
    LAS unsigned char* Vs = F.lds3; LAS float* rsv = (LAS float*)(F.lds3 + 128 * 288);
    const int fr = lane & 15, fq = lane >> 4;
    const int nitems = (nrows / 128) * 8;
    const int m = 16 * wave + fr;
    u32x4 vt[4]; f32x4 pq[4]; f32x4 wa[4][2]; u32x4 uwn[4]; f32x4 gvn[8]; float bsn = 0.f;
#define SGU_LOAD(it_) do { const int ch_ = (it_) >> 3, g_ = (it_) & 7, row0_ = ch_ * 128; \
        _Pragma("unroll") for (int i = 0; i < 4; ++i) { const int e = tid + i * 512, n = e >> 4, c16 = e & 15; vt[i] = *(const u32x4*)(V + (size_t)(row0_ + n) * RP + g_ * 128 + c16 * 8); } \
        if (tid < 128) { _Pragma("unroll") for (int i = 0; i < 4; ++i) pq[i] = *(const f32x4*)(PART + (size_t)(row0_ + tid) * 16 + i * 4); } \
        _Pragma("unroll") for (int ks = 0; ks < 4; ++ks) { const float* wp = w_s + ((size_t)g_ * 128 + m) * 128 + 32 * ks + 8 * fq; wa[ks][0] = *(const f32x4*)wp; wa[ks][1] = *(const f32x4*)(wp + 4); } \
        _Pragma("unroll") for (int cb = 0; cb < 4; ++cb) { const int col = g_ * 128 + 32 * cb + 8 * fq; uwn[cb] = *(const u32x4*)(U + (size_t)(row0_ + m) * RP + col); gvn[2 * cb] = *(const f32x4*)(vg + col); gvn[2 * cb + 1] = *(const f32x4*)(vg + col + 4); } \
        bsn = b_s[g_ * 128 + m]; } while (0)
    if (bid < nitems) SGU_LOAD(bid);
    for (int item = bid; item < nitems; item += G) {
        const int ch = item >> 3, g = item & 7, row0 = ch * 128;
        __syncthreads();
#pragma unroll
        for (int i = 0; i < 4; ++i) { const int e = tid + i * 512, n = e >> 4, c16 = e & 15; *(LAS u32x4*)(Vs + n * 288 + c16 * 16) = vt[i]; }
        if (tid < 128) { float sq = 0.f;
#pragma unroll
            for (int i = 0; i < 4; ++i) sq += (pq[i][0] + pq[i][1]) + (pq[i][2] + pq[i][3]);
            rsv[tid] = rsqrtf(sq * (1.f / D) + EPS); }
        __syncthreads();
        bf16x8 af[4];
#pragma unroll
        for (int ks = 0; ks < 4; ++ks) { const int k0 = 32 * ks + 8 * fq; const f32x4 a0 = wa[ks][0], a1 = wa[ks][1]; const f32x4 r0 = *(const LAS f32x4*)(rsv + k0), r1 = *(const LAS f32x4*)(rsv + k0 + 4);
            u32x4 w; w.x = pk2(a0[0] * r0[0], a0[1] * r0[1]); w.y = pk2(a0[2] * r0[2], a0[3] * r0[3]); w.z = pk2(a1[0] * r1[0], a1[1] * r1[1]); w.w = pk2(a1[2] * r1[2], a1[3] * r1[3]);
            af[ks] = __builtin_bit_cast(bf16x8, w); }
        u32x4 uw[4]; f32x4 gvv[8]; const float bsv = bsn;
#pragma unroll
        for (int cb = 0; cb < 4; ++cb) { uw[cb] = uwn[cb]; gvv[2 * cb] = gvn[2 * cb]; gvv[2 * cb + 1] = gvn[2 * cb + 1]; }
        asm volatile("" ::: "memory");
        if (item + G < nitems) SGU_LOAD(item + G);
        const int q = fr >> 2, pq2 = fr & 3;
#pragma unroll
        for (int cb = 0; cb < 4; ++cb) {
            f32x4 acc0 = {0.f, 0.f, 0.f, 0.f}, acc1 = {0.f, 0.f, 0.f, 0.f};
#pragma unroll
            for (int ks = 0; ks < 4; ++ks) {
                LAS unsigned char* ap = Vs + (32 * ks + 8 * fq + q) * 288 + (32 * cb + 8 * pq2) * 2;
                const v4i16_t lo = __builtin_amdgcn_ds_read_tr16_b64_v4i16((LAS v4i16_t*)ap), hi = __builtin_amdgcn_ds_read_tr16_b64_v4i16((LAS v4i16_t*)(ap + 4 * 288));
                const v4i16_t lo1 = __builtin_amdgcn_ds_read_tr16_b64_v4i16((LAS v4i16_t*)(ap + 8)), hi1 = __builtin_amdgcn_ds_read_tr16_b64_v4i16((LAS v4i16_t*)(ap + 8 + 4 * 288));
                const bf16x8 vf = {lo[0], lo[1], lo[2], lo[3], hi[0], hi[1], hi[2], hi[3]}, vf1 = {lo1[0], lo1[1], lo1[2], lo1[3], hi1[0], hi1[1], hi1[2], hi1[3]};
                acc0 = __builtin_amdgcn_mfma_f32_16x16x32_bf16(vf, af[ks], acc0, 0, 0, 0);
                acc1 = __builtin_amdgcn_mfma_f32_16x16x32_bf16(vf1, af[ks], acc1, 0, 0, 0);
            }
            const int col = g * 128 + 32 * cb + 8 * fq; const size_t off = (size_t)(row0 + m) * RP + col;
            const f32x4 gv0 = gvv[2 * cb], gv1 = gvv[2 * cb + 1]; const u32x4 uwv = uw[cb];
#define BFLO(x) __builtin_bit_cast(float, (x) << 16)
#define BFHI(x) __builtin_bit_cast(float, (x) & 0xffff0000u)
            u32x4 w;
            w.x = pk2(BFLO(uwv.x) * (acc0[0] * gv0[0] + bsv), BFHI(uwv.x) * (acc0[1] * gv0[1] + bsv)); w.y = pk2(BFLO(uwv.y) * (acc0[2] * gv0[2] + bsv), BFHI(uwv.y) * (acc0[3] * gv0[3] + bsv));
            w.z = pk2(BFLO(uwv.z) * (acc1[0] * gv1[0] + bsv), BFHI(uwv.z) * (acc1[1] * gv1[1] + bsv)); w.w = pk2(BFLO(uwv.w) * (acc1[2] * gv1[2] + bsv), BFHI(uwv.w) * (acc1[3] * gv1[3] + bsv));
#undef BFLO
#undef BFHI
            *(u32x4*)(Og + off) = w;
        }
    }
#undef SGU_LOAD
    __syncthreads();
}

__device__ __forceinline__ void p0_transpose_item(const float* W, int K, int N, bf16_t* WT, int ldw, int row_off, float* scr, int item, int lane) {
    const int nblk = N / 32, kb = item / nblk, nb = item % nblk, k0 = 64 * kb, n0 = 32 * nb;
    float wv[32];
#pragma unroll
    for (int i = 0; i < 32; ++i) wv[i] = __builtin_nontemporal_load(&W[(size_t)(k0 + 2 * i + (lane >> 5)) * N + n0 + (lane & 31)]);
#pragma unroll
    for (int i = 0; i < 32; ++i) scr[(2 * i + (lane >> 5)) * 33 + (lane & 31)] = wv[i];
    asm volatile("s_waitcnt lgkmcnt(0)" ::: "memory");
    const int c = lane & 7;
#pragma unroll
    for (int j = 0; j < 4; ++j) { const int n = (lane >> 3) + 8 * j; const float* s = scr + (8 * c) * 33 + n;
        u32x4 o; o.x = pk2(s[0 * 33], s[1 * 33]); o.y = pk2(s[2 * 33], s[3 * 33]); o.z = pk2(s[4 * 33], s[5 * 33]); o.w = pk2(s[6 * 33], s[7 * 33]);
        *(u32x4*)(WT + (size_t)(row_off + n0 + n) * ldw + k0 + 8 * c) = o; }
    asm volatile("s_waitcnt lgkmcnt(0)" ::: "memory");
}

template <int PART> __device__ __forceinline__ void p0_weights(const Frame& F, const Params& p, int rank, int nranks) {
    PHASE_IDS
    float* scr = F.lds + wave * (64 * 33);
    const int gw = rank * NWAVES + wave, NGW = nranks * NWAVES;
    constexpr int I_QKV = 16 * 48, I_WO_ = 16 * 32, I_POOL = 4 * 8, I_WIN = 16 * 64, I_WOUT = 16 * 32, I_UP = 16 * 176, I_DN = 44 * 32;
#define P0_UP(l, r_) p0_transpose_item(IN(I_WUP) + (size_t)(l) * D * FF2, D, FF2, WSP(bf16_t, WS_WUP) + (size_t)(l) * FF2 * RP, RP, 0, scr, (r_), lane)
#define P0_QKV(j, r_) p0_transpose_item(IN(I_WQKV) + (size_t)(j) * D * QKVW, D, QKVW, WSP(bf16_t, WS_WQKV) + (size_t)(j) * QKVW * RP, RP, 0, scr, (r_), lane)
    if (PART == 0) {
        for (int it = gw; it < I_QKV + I_WO_ + 2 * I_UP; it += NGW) {
            int r = it;
            if (r < I_QKV) { P0_QKV(0, r); continue; } r -= I_QKV;
            if (r < I_WO_) { p0_transpose_item(IN(I_WO), D, D, WSP(bf16_t, WS_WO), RP, 0, scr, r, lane); continue; } r -= I_WO_;
            { const int l = r / I_UP; P0_UP(l, r % I_UP); }
        }
    } else if (PART == 1) {
        for (int it = gw; it < I_WO_ + 4 * I_POOL + I_WOUT + 4 * I_DN; it += NGW) {
            int r = it;
            if (r < I_WO_) { p0_transpose_item(IN(I_WO) + (size_t)D * D, D, D, WSP(bf16_t, WS_WO) + (size_t)D * RP, RP, 0, scr, r, lane); continue; } r -= I_WO_;
            if (r < 4 * I_POOL) { const int g = r / I_POOL; p0_transpose_item(IN(I_POOLW) + (size_t)g * 65536, 256, 256, WSP(bf16_t, WS_WPOOL), RPP, g * 256, scr, r % I_POOL, lane); continue; } r -= 4 * I_POOL;
            if (r < I_WOUT) { p0_transpose_item(IN(I_SWOUT), D, D, WSP(bf16_t, WS_WOUT), RP, 0, scr, r, lane); continue; } r -= I_WOUT;
            { const int l = r / I_DN; p0_transpose_item(IN(I_WDN) + (size_t)l * FF * D, FF, D, WSP(bf16_t, WS_WDN) + (size_t)l * D * FF, FF, 0, scr, r % I_DN, lane); }
        }
    } else if (PART == 2) {
        for (int it = gw; it < I_WIN; it += NGW) p0_transpose_item(IN(I_SWIN), D, 2048, WSP(bf16_t, WS_WIN), RP, 0, scr, it, lane);
    } else if (PART == 3) {
        for (int it = gw; it < I_UP; it += NGW) P0_UP(2, it);
    } else {
        for (int it = gw; it < I_QKV + I_UP; it += NGW) { if (it < I_QKV) P0_QKV(1, it); else P0_UP(3, it - I_QKV); }
    }
#undef P0_UP
#undef P0_QKV
}

__device__ __forceinline__ void p0_mod(const Frame& F, const Params& p, int layer, int rank, int nranks) {
    PHASE_IDS
    float* sv = F.lds;
    float* red = F.lds + 5 * 1024;
    const float* cvec = IN(I_C); const float* cctx = IN(I_CCTX); const float* ada_w = IN(I_ADAW); const float* ada_b = IN(I_ADAB); float* MOD = WSP(float, WS_MOD);
    for (int i = tid; i < 5 * 1024; i += NT) { const int v = i >> 10, k = i & 1023; const float xv = v < 4 ? cvec[v * D + k] : cctx[k]; sv[i] = silu_f(xv); }
    __syncthreads();
    const int cg4 = tid & 7, kr = tid >> 3;
    for (int item = rank; item < 192; item += nranks) {
        const int n0 = item * 32;
        const float* W = ada_w + (size_t)layer * D * 6144 + n0 + cg4 * 4;
        float acc[5][4];
#pragma unroll
        for (int v = 0; v < 5; ++v)
#pragma unroll
            for (int j = 0; j < 4; ++j) acc[v][j] = 0.f;
#pragma unroll 8
        for (int k = kr; k < D; k += 64) {
            const f32x4 w_ = __builtin_nontemporal_load((const f32x4*)(W + (size_t)k * 6144)); const float4 w = {w_[0], w_[1], w_[2], w_[3]};
#pragma unroll
            for (int v = 0; v < 5; ++v) { const float s = sv[v * 1024 + k]; acc[v][0] += s * w.x; acc[v][1] += s * w.y; acc[v][2] += s * w.z; acc[v][3] += s * w.w; }
        }
        __syncthreads();
#pragma unroll
        for (int v = 0; v < 5; ++v)
#pragma unroll
            for (int j = 0; j < 4; ++j) red[(kr * 5 + v) * 32 + cg4 * 4 + j] = acc[v][j];
        __syncthreads();
        if (tid < 160) {
            const int v = tid >> 5, col = tid & 31;
            float s = 0.f;
            for (int q = 0; q < 64; ++q) s += red[(q * 5 + v) * 32 + col];
            MOD[(size_t)(layer * 5 + v) * 6144 + n0 + col] = s + ada_b[layer * 6144 + n0 + col];
        }
        __syncthreads();
    }
}

__device__ __forceinline__ void final_norm(const Frame& F, const float* fnw) {
    PHASE_IDS
    const bf16_t* XB = WSP(bf16_t, WS_XB);
    for (int r2 = bid * 8 + wave; r2 < NLAT / 2; r2 += G * 8) {
        u32x2 w[2][4];
#pragma unroll
        for (int q = 0; q < 2; ++q)
#pragma unroll
            for (int j = 0; j < 4; ++j) w[q][j] = *(const u32x2*)(XB + (size_t)(2 * r2 + q) * RP + j * 256 + lane * 4);
#pragma unroll
        for (int q = 0; q < 2; ++q) { float* orow = F.X + (size_t)(2 * r2 + q) * D; f32x4 xv[4]; float ss = 0.f;
#pragma unroll
            for (int j = 0; j < 4; ++j) { xv[j] = unpkh4(w[q][j]); ss += (xv[j][0] * xv[j][0] + xv[j][1] * xv[j][1]) + (xv[j][2] * xv[j][2] + xv[j][3] * xv[j][3]); }
            const float rs = rsqrtf(wave_sum(ss) * (1.f / D) + EPS);
#pragma unroll
            for (int j = 0; j < 4; ++j) { const int c = j * 256 + lane * 4; __builtin_nontemporal_store(xv[j] * rs * *(const f32x4*)(fnw + c), (f32x4*)(orow + c)); } }
    }
}


__device__ __forceinline__ void p0_rope(const Frame& F) {
    PHASE_IDS
    if (bid < 16 && tid < 64) { float* rc = WSP(float, WS_ROPE); float* rsn = rc + 1024;
        { const int i = bid * 64 + tid; const int pos = i >> 4, fi = i & 15; const float ang = (float)pos * powf(10000.f, -(float)fi / 16.f); rc[i] = cosf(ang); rsn[i] = sinf(ang); } }
}
__device__ __forceinline__ void attn_phase(const Frame& F, const float* qg, const float* kg, bool with_ctx) {
    PHASE_IDS
    float gqm = 0.f, gkm = 0.f;
    for (int i = 0; i < HD; ++i) { gqm = fmaxf(gqm, fabsf(qg[i])); gkm = fmaxf(gkm, fabsf(kg[i])); }
    const float m2 = 8.f * gqm * gkm * 1.4426950408889634f;
    bf16_t* Q = WSP(bf16_t, WS_Q); const bf16_t* K = WSP(bf16_t, WS_K); const bf16_t* V = WSP(bf16_t, WS_V);
    const int vcu = (G % 8 == 0) ? (bid % 8) * (G / 8) + bid / 8 : bid;
    for (int s = vcu; s < 256; s += G) {
        const int pair = s >> 4, b = pair >> 2, kvh = pair & 3, qb = s & 15;
        attn_body::attn_unit(b * L + qb * 256, kvh * 4, 4, b * (LC + L), kvh, (LC + L) / 64, m2, Q, K, V, (char*)F.lds);
    }
    if (with_ctx) for (int s = vcu; s < 64; s += G) { const int b = s >> 4, h = s & 15; attn_body::attn_unit(NLAT + b * LC, h, 1, b * (LC + L), h >> 2, LC / 64, m2, Q, K, V, (char*)F.lds); }
}


template <int SET> __device__ __forceinline__ void bias_gemv(const Frame& F, int rank, int nranks) {
    PHASE_IDS
    const int gw = rank * NWAVES + wave, NGW = nranks * NWAVES;
    const float* MOD = WSP(float, WS_MOD); float* BW = WSP(float, WS_BIASW);
    LAS bf16_t* shb = (LAS bf16_t*)F.lds3;
    constexpr int NSEG = SET == 1 ? 1 : 2; constexpr int SEGA = SET == 0 ? 0 : SET == 1 ? 4 : SET == 2 ? 2 : 1, SEGB = SET == 0 ? 3 : SET == 2 ? 5 : 6;
    for (int i = tid; i < NSEG * 5 * 256; i += NT) { const int si = i / 1280, r = i % 1280, v = r >> 8, k4 = (r & 255) * 4;
        const int seg = si == 0 ? SEGA : SEGB;
        const int layer = seg < 2 ? 3 * seg : seg == 2 ? 2 : seg - 3, part = seg < 3 ? 0 : 3;
        const f32x4 x = *(const f32x4*)(MOD + ((size_t)(layer * 5 + v) * 6 + part) * D + k4);
        u32x2 w; w.x = pk2(x[0], x[1]); w.y = pk2(x[2], x[3]); *(LAS u32x2*)(shb + (seg * 5 + v) * 1024 + k4) = w; }
    __syncthreads();
    const int fr = lane & 15, fq = lane >> 4;
    constexpr int NG_QKV = QKVW / 16, NG_WIN = 2048 / 16, NG_UP = FF2 / 16, NGA = SEGA < 2 ? NG_QKV : SEGA == 2 ? NG_WIN : NG_UP, NG_ALL = NGA + (NSEG == 2 ? NG_UP : 0);
    for (int gi = gw; gi < NG_ALL; gi += NGW) {
        int seg, grp; const bf16_t* Wt; int N;
        if (gi < NGA) { seg = SEGA; grp = gi; } else { seg = SEGB; grp = gi - NGA; }
        if (seg < 2) { Wt = WSP(bf16_t, WS_WQKV) + (size_t)seg * QKVW * RP; N = QKVW; } else if (seg == 2) { Wt = WSP(bf16_t, WS_WIN); N = 2048; } else { Wt = WSP(bf16_t, WS_WUP) + (size_t)(seg - 3) * FF2 * RP; N = FF2; }
        const bf16_t* wrow = Wt + (size_t)(grp * 16 + fr) * RP + 8 * fq;
        const LAS bf16_t* srow = shb + (seg * 5 + (fr < 5 ? fr : 0)) * 1024 + 8 * fq;
        f32x4 acc = {0.f, 0.f, 0.f, 0.f};
#pragma unroll
        for (int kb = 0; kb < 4; ++kb) { bf16x8 bfr[8];
#pragma unroll
            for (int j = 0; j < 8; ++j) bfr[j] = *(const bf16x8*)(wrow + (kb * 8 + j) * 32);
#pragma unroll
            for (int j = 0; j < 8; ++j) { bf16x8 afr = *(const LAS bf16x8*)(srow + (kb * 8 + j) * 32); if (fr >= 5) afr = (bf16x8){0, 0, 0, 0, 0, 0, 0, 0};
                acc = __builtin_amdgcn_mfma_f32_16x16x32_bf16(afr, bfr[j], acc, 0, 0, 0); } }
        const int n = grp * 16 + fr; float* out = seg < 2 ? BW + BW_QKV + (size_t)seg * 5 * QKVW : seg == 2 ? BW + BW_WIN : BW + BW_UP + (size_t)(seg - 3) * 5 * FF2;
        const int half = n >= FF, f = n - half * FF;
#pragma unroll
        for (int reg = 0; reg < 4; ++reg) { const int v = 4 * fq + reg;
            if (v < 5) { if (seg < 3) out[(size_t)v * N + n] = acc[reg]; else out[((size_t)v * 22 + (f >> 7)) * 256 + half * 128 + (f & 127)] = acc[reg]; } }
    }
    __syncthreads();
}

__device__ __forceinline__ void p1_prep(const Frame& F, const Params& p) {
    PHASE_IDS
    const int gw = bid * NWAVES + wave, NGW = G * NWAVES;
    const float* MOD = WSP(float, WS_MOD); float* BW = WSP(float, WS_BIASW);
    bias_gemv<0>(F, bid, G);
    {
        const float* cw = IN(I_CONVW); const float* cb = IN(I_CONVB); float* CP = BW + BW_CONVP;
        for (int i = bid * NT + tid; i < 4 * 22 * 1024; i += G * NT) { const int l = i / (22 * 1024), r = i % (22 * 1024), pn = r >> 10, k = (r >> 8) & 3, half = (r >> 7) & 1, e = r & 127;
            const int col = half * FF + pn * 128 + e; CP[i] = (k < 3 ? cw[(size_t)(l * 3 + k) * FF2 + col] : cb[(size_t)l * FF2 + col]) * (half ? -1.4426950408889634f : -0.6931471805599453f); }
        if (bid == 0) { const float* qg = IN(I_QG); const float* kg = IN(I_KG); float* GP = BW + BW_GAINP;
            for (int i = tid; i < 512; i += NT) { const int j = i >> 8, e = i & 255; GP[i] = e < 64 ? qg[j * 64 + e] : e < 128 ? kg[j * 64 + e - 64] : 0.f; } }
    }
    {
        const float* xl = IN(I_X); const float* xc = IN(I_CTX); const float* nw = IN(I_NORMW); bf16_t* H = WSP(bf16_t, WS_H); float* PARTX = WSP(float, WS_PARTX);
        for (int r2 = gw; r2 < NTOK / 2; r2 += NGW) {
            f32x4 xv[2][4]; float ss[2] = {0.f, 0.f};
#pragma unroll
            for (int q = 0; q < 2; ++q) { const int r = 2 * r2 + q; const float* xr = r < NLAT ? xl + (size_t)r * D : xc + (size_t)(r - NLAT) * D;
#pragma unroll
                for (int jj = 0; jj < 4; ++jj) xv[q][jj] = __builtin_nontemporal_load((const f32x4*)(xr + jj * 256 + lane * 4)); }
#pragma unroll
            for (int q = 0; q < 2; ++q) { const int r = 2 * r2 + q; const float* sc = MOD + ((size_t)vidx(r) * 6 + 1) * D;
#pragma unroll
                for (int jj = 0; jj < 4; ++jj) { const int c = jj * 256 + lane * 4; const f32x4 x = xv[q][jj];
                    ss[q] += (x[0] * x[0] + x[1] * x[1]) + (x[2] * x[2] + x[3] * x[3]);
                    const f32x4 hv = x * (*(const f32x4*)(nw + c)) * (*(const f32x4*)(sc + c) + 1.f);
                    u32x2 w; w.x = pk2(hv[0], hv[1]); w.y = pk2(hv[2], hv[3]); *(u32x2*)(H + (size_t)r * RP + c) = w;
                    u32x2 xw; xw.x = pkh2(x[0], x[1]); xw.y = pkh2(x[2], x[3]); *(u32x2*)(WSP(bf16_t, WS_XB) + (size_t)r * RP + c) = xw; }
                const float t = wave_sum(ss[q]);
                if (lane < 4) PARTX[(size_t)r * 4 + lane] = lane == 0 ? t : 0.f; }
        }
    }
}

template <int WIN> __device__ __forceinline__ void pool_rows(const bf16_t* Hs, const LAS float* rsl, bf16_t* P, int r0, int half, int c, int sbase, int Ls) {
    f32x4 pre[32];
    u32x2 raw[31];
#pragma unroll
    for (int i = 0; i < 31; ++i) { int row = r0 + 16 * half - 8 + i; row = row < 0 ? 0 : (row > NTOK - 1 ? NTOK - 1 : row); raw[i] = *(const u32x2*)(Hs + (size_t)row * RP + c); }
    pre[0] = (f32x4){0.f, 0.f, 0.f, 0.f};
#pragma unroll
    for (int i = 0; i < 31; ++i) { const float rsv = rsl[16 * half + i];
        const f32x4 v = {__builtin_bit_cast(float, raw[i].x << 16), __builtin_bit_cast(float, raw[i].x & 0xffff0000u), __builtin_bit_cast(float, raw[i].y << 16), __builtin_bit_cast(float, raw[i].y & 0xffff0000u)};
        pre[i + 1] = pre[i] + v * rsv; }
#pragma unroll
    for (int q = 0; q < 16; ++q) {
        const int i = q + 8;
        const int t = r0 + 16 * half + q - sbase;
        int lo = t - WIN / 2; if (lo < 0) lo = 0;
        int hi = t + WIN - WIN / 2 - 1; if (hi > Ls - 1) hi = Ls - 1;
        const float ic = 1.f / (float)(hi - lo + 1);
        const f32x4 wsum = pre[i + WIN - WIN / 2] - pre[i - WIN / 2], self = pre[i + 1] - pre[i];
        const f32x4 o = wsum * ic - self;
        u32x2 w; w.x = pk2(o[0], o[1]); w.y = pk2(o[2], o[3]);
        *(u32x2*)(P + (size_t)(r0 + 16 * half + q) * RP + c) = w;
    }
}
__device__ __forceinline__ void pool_prep2(const Frame& F, const bf16_t* Hs, const float* PARTX, bf16_t* P) {
    PHASE_IDS
    LAS float* rsl = (LAS float*)F.lds3;
    const int half = tid >> 8, c = (tid & 255) * 4, g = (wave & 3);
    for (int tile = bid; tile < NTOK / 32; tile += G) {
        const int r0 = tile * 32; int sbase, Ls;
        if (r0 < NLAT) { sbase = r0 & ~(L - 1); Ls = L; } else { sbase = NLAT + ((r0 - NLAT) & ~(LC - 1)); Ls = LC; }
        __syncthreads();
        if (tid < 48) { const int rr = r0 - 8 + tid; float rsv = 0.f;
            if (rr >= sbase && rr < sbase + Ls) { const f32x4 q = *(const f32x4*)(PARTX + (size_t)rr * 4);
                rsv = rsqrtf(((q[0] + q[1]) + (q[2] + q[3])) * (1.f / D) + EPS); }
            rsl[tid] = rsv; }
        __syncthreads();
        if (g == 0) pool_rows<2>(Hs, rsl, P, r0, half, c, sbase, Ls);
        else if (g == 1) pool_rows<4>(Hs, rsl, P, r0, half, c, sbase, Ls);
        else if (g == 2) pool_rows<8>(Hs, rsl, P, r0, half, c, sbase, Ls);
        else pool_rows<16>(Hs, rsl, P, r0, half, c, sbase, Ls);
    }
    __syncthreads();
}

__device__ __forceinline__ void pool_prep_units(const Frame& F, const pg8::StaticOrder& S, const bf16_t* Hs, const float* PARTX, bf16_t* P) {
    PHASE_IDS
    LAS float* rsl = (LAS float*)F.lds3;
    for (int i = 0; ; ++i) { pg8::Unit u; if (!S.next(i, u)) break;
        const int rt = u.pm * 256, g = u.pn; int sbase, Ls;
        if (rt < NLAT) { sbase = rt & ~(L - 1); Ls = L; } else { sbase = NLAT + ((rt - NLAT) & ~(LC - 1)); Ls = LC; }
        __syncthreads();
        if (tid < 272) { const int rr = rt - 8 + tid; float rsv = 0.f;
            if (rr >= sbase && rr < sbase + Ls) { const f32x4 q = *(const f32x4*)(PARTX + (size_t)rr * 4);
                rsv = rsqrtf(((q[0] + q[1]) + (q[2] + q[3])) * (1.f / D) + EPS); }
            rsl[tid] = rsv; }
        __syncthreads();
        const int c = g * 256 + lane * 4;
#pragma unroll 1
        for (int k = 0; k < 2; ++k) { const int rb = wave + 8 * k;
            if (g == 0) pool_rows<2>(Hs, rsl, P, rt, rb, c, sbase, Ls);
            else if (g == 1) pool_rows<4>(Hs, rsl, P, rt, rb, c, sbase, Ls);
            else if (g == 2) pool_rows<8>(Hs, rsl, P, rt, rb, c, sbase, Ls);
            else pool_rows<16>(Hs, rsl, P, rt, rb, c, sbase, Ls); }
    }
    asm volatile("s_waitcnt vmcnt(0)" ::: "memory");
    __syncthreads();
}

__device__ __forceinline__ void final_fused(const Frame& F, const pg8::StreamOrder& S, const float* fnw) {
    PHASE_IDS
    pg8::Unit u; if (!S.next(0, u)) return;
    const int rt = u.pm * 256, c0 = u.pn * 256;
    LAS float* rsl = (LAS float*)F.lds3;
    asm volatile("s_waitcnt vmcnt(0)" ::: "memory"); __syncthreads();
    if (tid == 0) { unsigned* cw = (unsigned*)(F.ws + WS_ZERO) + u.pm * 16; __hip_atomic_fetch_add(cw, 1u, __ATOMIC_RELAXED, __HIP_MEMORY_SCOPE_AGENT); unsigned sp = 0;
        while (__hip_atomic_load(cw, __ATOMIC_RELAXED, __HIP_MEMORY_SCOPE_AGENT) < 4u) { __builtin_amdgcn_s_sleep(1); if (++sp > (1u << 22)) break; }
        __builtin_amdgcn_fence(__ATOMIC_ACQUIRE, "agent"); }
    __syncthreads();
    if (tid < 256) { const f32x4 q = *(const f32x4*)(WSP(float, WS_PARTX) + (size_t)(rt + tid) * 4); rsl[tid] = rsqrtf(((q[0] + q[1]) + (q[2] + q[3])) * (1.f / D) + EPS); }
    __syncthreads();
    const bf16_t* XB = WSP(bf16_t, WS_XB); const f32x4 fw = *(const f32x4*)(fnw + c0 + lane * 4);
#pragma unroll 1
    for (int rb = 0; rb < 2; ++rb) {
        u32x2 w[16];
#pragma unroll
        for (int i = 0; i < 16; ++i) w[i] = *(const u32x2*)(XB + (size_t)(rt + wave + NWAVES * (16 * rb + i)) * RP + c0 + lane * 4);
#pragma unroll
        for (int i = 0; i < 16; ++i) { const int r = wave + NWAVES * (16 * rb + i);
            __builtin_nontemporal_store(unpkh4(w[i]) * rsl[r] * fw, (f32x4*)(F.X + (size_t)(rt + r) * D + c0 + lane * 4)); }
    }
}

__global__ void __launch_bounds__(NT, 2) fwd_kernel(Params p) {
    extern __shared__ __attribute__((aligned(16))) unsigned char lds_raw[];
    cg::grid_group grid = cg::this_grid();
    Frame F;
    F.ws = p.ws; F.X = p.out;
    F.lds3 = (LAS unsigned char*)lds_raw; F.lds = (float*)lds_raw;
    const int G = gridDim.x, bid = blockIdx.x;
    for (int u = threadIdx.x; u < (LDS_BYTES - LDSCTL_OFF) / 4; u += NT) ((LAS unsigned*)(F.lds3 + LDSCTL_OFF))[u] = 0u;
    __syncthreads();
    volatile LAS unsigned* MISC = (volatile LAS unsigned*)(F.lds3 + MISC_OFF);
    XcdBarrier bar = xcd_barrier_post(WSP(unsigned, WS_CTL) + 1024, MISC + 8);
#define GRID_BAR() xcd_barrier(bar)
    const size_t STD_UNIT = (size_t)256 * RP * 2, STD_HALF = (size_t)128 * RP * 2;

    p0_weights<0>(F, p, (G == 256) ? (((bid & 64) ? 0 : 128) + (bid & 63) + ((bid >> 7) << 6)) : bid, G);
    __syncthreads();
    p0_mod(F, p, 0, bid, G); p0_mod(F, p, 1, (bid + G / 2) % G, G);
    p0_rope(F);
    GRID_BAR();
    p1_prep(F, p);
    GRID_BAR();
    if (p.ws == nullptr) grid.sync();
    for (int layer = 0; layer < DEPTH; ++layer) {
        int lg = G, lb = bid; asm volatile("" : "+s"(lg), "+s"(lb));
        const int kind = layer % 3, j = layer / 3; const bool last = layer == DEPTH - 1;
        const int nrows_res = last ? NLAT : NTOK;
        const float* mod_layer = WSP(float, WS_MOD) + (size_t)layer * 5 * 6144;
        if (kind == 0) {
            { PHASE_IDS const float* rt_ = WSP(float, WS_ROPE); *(LAS f32x4*)(F.lds3 + ROPE_OFF + tid * 16) = *(const f32x4*)(rt_ + tid * 4); }
            { pg8::Gemm g{WSP(bf16_t, WS_H), WSP(bf16_t, WS_WQKV) + (size_t)j * QKVW * RP, RP, RP, D, 0, STD_UNIT, (size_t)16 * RP * 2}; pg8::StaticOrder S; S.init(NTOK, QKVW, lg, lb);
              EpiQKV E{WSP(bf16_t, WS_Q), WSP(bf16_t, WS_K), (WS_V - WS_K) / 2, WSP(float, WS_BIASW) + BW_GAINP + (size_t)j * 256, WSP(float, WS_PARTX), WSP(float, WS_BIASW) + BW_QKV + (size_t)j * 5 * QKVW, (LAS float*)(F.lds3 + PRM_OFF), (const LAS float*)(F.lds3 + ROPE_OFF)};
              pg8::gemm_phase<EpiQKV, pg8::StaticOrder, true>(F.lds3, g, S, E); }
            if (layer == 0) { int fi = (NTOK / 256) * (QKVW / 256) - G; if (fi < 0 || fi >= G) fi = 0;
                if (bid >= fi) { __syncthreads(); p0_weights<1>(F, p, bid - fi, G - fi); } }
            GRID_BAR();
            attn_phase(F, IN(I_QG) + j * HD, IN(I_KG) + j * HD, !last);
            GRID_BAR();
            { pg8::Gemm g{WSP(bf16_t, WS_Q), WSP(bf16_t, WS_WO) + (size_t)j * D * RP, RP, RP, D, 0, STD_UNIT, STD_HALF}; pg8::StreamOrder S0, S; S0.init(nrows_res, D, D, lg, lb, 0); S.init(nrows_res, D, D, lg, lb, 1);
              EpiResid<false> E{WSP(bf16_t, WS_XB), mod_layer, 2, nullptr, nullptr, WSP(bf16_t, WS_H), WSP(float, WS_PARTX), IN(I_NORMW) + (size_t)(layer * 2 + 1) * D, mod_layer, 4, (LAS float*)(F.lds3 + XB_OFF + 2048), (LAS float*)(F.lds3 + PRM_OFF)};
              EpiTailT<EpiResid<false>> ET{WSP(float, WS_BIG1), (unsigned*)(F.ws + WS_SFLAG + (size_t)j * SFLAG_PHASE)}; pg8::gemm_phase<EpiTailT<EpiResid<false>>, pg8::StreamOrder, true>(F.lds3, g, S0, ET);
              EpiHead<EpiResid<false>> ES{E, WSP(float, WS_BIG1), (unsigned*)(F.ws + WS_SFLAG + (size_t)j * SFLAG_PHASE), F.lds3};
              pg8::gemm_phase<EpiHead<EpiResid<false>>, pg8::StreamOrder, true>(F.lds3, g, S, ES); }
            GRID_BAR();
        } else if (kind == 1) {
            { pg8::Gemm g{WSP(bf16_t, WS_BIG2), WSP(bf16_t, WS_WPOOL), RP, RPP, 256, (size_t)256 * 2, (size_t)256 * RPP * 2, (size_t)128 * RPP * 2}; pg8::StaticOrder S; S.init(nrows_res, D, lg, lb);
              pool_prep_units(F, S, WSP(bf16_t, WS_H), WSP(float, WS_PARTX), WSP(bf16_t, WS_BIG2));
              EpiResid<true> E{WSP(bf16_t, WS_XB), mod_layer, 2, IN(I_POOLB) + (size_t)j * D, IN(I_POOLS) + (size_t)j * D, WSP(bf16_t, WS_H), WSP(float, WS_PARTX), IN(I_NORMW) + (size_t)(layer * 2 + 1) * D, mod_layer, 4, (LAS float*)(F.lds3 + XB_OFF + 2048), (LAS float*)(F.lds3 + PRM_OFF)};
              pg8::gemm_phase<EpiResid<true>, pg8::StaticOrder, true>(F.lds3, g, S, E); }
            { const int nwg_ = (nrows_res / 256) * 4; int fi = nwg_ - ((nwg_ - 1) / G) * G; if (fi < 0 || fi >= G) fi = 0;
              if (bid >= fi && layer + 1 < DEPTH) { __syncthreads(); p0_mod(F, p, layer + 1, bid - fi, G - fi); __syncthreads(); p0_weights<3>(F, p, bid - fi, G - fi); } }
            GRID_BAR();
        } else {
            { pg8::Gemm g{WSP(bf16_t, WS_H), WSP(bf16_t, WS_WIN), RP, RP, D, 0, STD_UNIT, STD_HALF}; pg8::StaticOrder S; S.init(nrows_res, 2048, lg, lb);
              EpiGelu E{WSP(bf16_t, WS_SU), WSP(bf16_t, WS_SV), WSP(float, WS_SPART), WSP(float, WS_PARTX), WSP(float, WS_BIASW) + BW_WIN, (LAS float*)(F.lds3 + PRM_OFF)}; pg8::gemm_phase<EpiGelu, pg8::StaticOrder, true>(F.lds3, g, S, E); }
            { const int nwg_ = (nrows_res / 256) * 8; int fi = nwg_ - ((nwg_ - 1) / G) * G; if (fi < 0 || fi >= G) fi = 0;
              if (bid >= fi && layer + 1 < DEPTH) { __syncthreads(); p0_mod(F, p, layer + 1, bid - fi, G - fi); __syncthreads(); p0_weights<4>(F, p, bid - fi, G - fi); } }
            GRID_BAR();
            sgu_spatial(F, IN(I_SWS) + (size_t)j * 8 * 16384, IN(I_SBS) + (size_t)j * 8 * 128, IN(I_SVG) + (size_t)j * D, WSP(bf16_t, WS_SU), WSP(bf16_t, WS_SV), WSP(float, WS_SPART), WSP(bf16_t, WS_BIG2), nrows_res);
            GRID_BAR();
            { pg8::Gemm g{WSP(bf16_t, WS_BIG2), WSP(bf16_t, WS_WOUT), RP, RP, D, 0, STD_UNIT, STD_HALF}; pg8::StreamOrder S0, S; S0.init(nrows_res, D, D, lg, lb, 0); S.init(nrows_res, D, D, lg, lb, 1);
              EpiResid<false> E{WSP(bf16_t, WS_XB), mod_layer, 2, nullptr, nullptr, WSP(bf16_t, WS_H), WSP(float, WS_PARTX), IN(I_NORMW) + (size_t)(layer * 2 + 1) * D, mod_layer, 4, (LAS float*)(F.lds3 + XB_OFF + 2048), (LAS float*)(F.lds3 + PRM_OFF)};
              EpiTailT<EpiResid<false>> ET{WSP(float, WS_BIG1), (unsigned*)(F.ws + WS_SFLAG + (size_t)2 * SFLAG_PHASE)}; pg8::gemm_phase<EpiTailT<EpiResid<false>>, pg8::StreamOrder, true>(F.lds3, g, S0, ET);
              EpiHead<EpiResid<false>> ES{E, WSP(float, WS_BIG1), (unsigned*)(F.ws + WS_SFLAG + (size_t)2 * SFLAG_PHASE), F.lds3};
              pg8::gemm_phase<EpiHead<EpiResid<false>>, pg8::StreamOrder, true>(F.lds3, g, S, ES); }
            GRID_BAR();
        }
        const bool fuse_fin = last && G * 256 == NLAT * 4;
        { pg8::Gemm g{WSP(bf16_t, WS_H), WSP(bf16_t, WS_WUP) + (size_t)layer * FF2 * RP, RP, RP, D, 0, (size_t)128 * RP * 2, (size_t)FF * RP * 2}; pg8::StaticOrder S; S.init(nrows_res, FF2, lg, lb);
          EpiUpConv E{WSP(bf16_t, WS_BIG1), WSP(float, WS_EDGE), WSP(float, WS_BIASW) + BW_CONVP + (size_t)layer * 22 * 1024, (LAS float*)(F.lds3 + XB_OFF), WSP(float, WS_PARTX), WSP(float, WS_BIASW) + BW_UP + (size_t)layer * 5 * FF2, (LAS float*)(F.lds3 + PRM_OFF)};
          pg8::gemm_phase<EpiUpConv, pg8::StaticOrder, true>(F.lds3, g, S, E); }
        if (!last) { const int nwg_ = (nrows_res / 256) * 22; int fi = nwg_ - ((nwg_ - 1) / G) * G; if (fi < 0 || fi >= G) fi = 0;
            if (bid >= fi) { __syncthreads(); if (layer == 0) { bias_gemv<1>(F, bid - fi, G - fi); p0_weights<2>(F, p, bid - fi, G - fi); } else if (layer == 1) bias_gemv<2>(F, bid - fi, G - fi); else bias_gemv<3>(F, bid - fi, G - fi); } }
        GRID_BAR();
        ffn_fixup(F, IN(I_CONVW) + (size_t)layer * 3 * FF2, IN(I_CONVB) + (size_t)layer * FF2, WSP(float, WS_EDGE), WSP(bf16_t, WS_BIG1));
        GRID_BAR();
        { pg8::Gemm g{WSP(bf16_t, WS_BIG1), WSP(bf16_t, WS_WDN) + (size_t)layer * D * FF, FF, FF, FF, 0, (size_t)256 * FF * 2, (size_t)128 * FF * 2}; pg8::StreamOrder S0, S; S0.init(nrows_res, D, FF, lg, lb, 0); S.init(nrows_res, D, FF, lg, lb, 1);
          EpiResid<false, true> E{WSP(bf16_t, WS_XB), mod_layer, 5, nullptr, nullptr, last ? nullptr : WSP(bf16_t, WS_H), WSP(float, WS_PARTX), IN(I_NORMW) + (size_t)((layer + 1) * 2) * D, WSP(float, WS_MOD) + (size_t)(layer + 1) * 5 * 6144, fuse_fin ? 99 : 1, (LAS float*)(F.lds3 + XB_OFF + 2048), (LAS float*)(F.lds3 + PRM_OFF)};
          EpiTailT<EpiResid<false, true>> ET{WSP(float, WS_BIG2), (unsigned*)(F.ws + WS_SFLAG + (size_t)(3 + layer) * SFLAG_PHASE)}; pg8::gemm_phase<EpiTailT<EpiResid<false, true>>, pg8::StreamOrder, true>(F.lds3, g, S0, ET);
              EpiHead<EpiResid<false, true>> ES{E, WSP(float, WS_BIG2), (unsigned*)(F.ws + WS_SFLAG + (size_t)(3 + layer) * SFLAG_PHASE), F.lds3};
              pg8::gemm_phase<EpiHead<EpiResid<false, true>>, pg8::StreamOrder, true>(F.lds3, g, S, ES);
              if (fuse_fin) { final_fused(F, S, IN(I_FNORM)); return; } }
        GRID_BAR();
    }
    final_norm(F, IN(I_FNORM));
}

extern "C" void kernel_launch(void* const* d_in, const int* in_sizes, int n_in, void* d_out, int out_size, void* d_ws, size_t ws_size, hipStream_t stream) {
    constexpr size_t kDynLds = LDS_BYTES;
    static int grid_blocks = 0;
    if (!grid_blocks) {
        int dev = 0, cus = 0, per_cu = 0;
        (void)hipGetDevice(&dev);
        (void)hipDeviceGetAttribute(&cus, hipDeviceAttributeMultiprocessorCount, dev);
        (void)hipFuncSetAttribute((const void*)fwd_kernel, hipFuncAttributeMaxDynamicSharedMemorySize, (int)kDynLds);
        (void)hipOccupancyMaxActiveBlocksPerMultiprocessor(&per_cu, fwd_kernel, NT, kDynLds);
        if (per_cu < 1) fprintf(stderr, "occupancy query returned %d\n", per_cu);
        grid_blocks = cus;
        if (ws_size < WS_END) fprintf(stderr, "workspace too small: %zu < %zu\n", ws_size, (size_t)WS_END);
    }
    (void)hipMemsetAsync((char*)d_ws + WS_CTL, 0, CTL_ZERO_BYTES, stream);
    Params p{};
    for (int i = 0; i < 24; ++i) p.in[i] = (const float*)d_in[i];
    p.out = (float*)d_out; p.ws = (unsigned char*)d_ws;
    void* args[] = {&p};
    hipError_t e = hipLaunchCooperativeKernel((void*)fwd_kernel, dim3(grid_blocks), dim3(NT), args, kDynLds, stream);
    if (e != hipSuccess) fprintf(stderr, "cooperative launch failed: %s (grid %d)\n", hipGetErrorString(e), grid_blocks);
}
```

```cpp
#include <hip/hip_runtime.h>
#include <hip/hip_cooperative_groups.h>
#include <cstdio>
#include <cstdint>
namespace cg = cooperative_groups;

constexpr int D = 1024, NB = 4, L = 4096, LC = 256, DEPTH = 4;
constexpr int NLAT = NB * L, NCTX = NB * LC, NTOK = NLAT + NCTX;
constexpr int FF = 2816, FF2 = 5632;
constexpr int NH = 16, HD = 64, NKV = 4, QKVW = 1536;
constexpr float EPS = 1e-6f;
constexpr int NT = 512;
constexpr int NWAVES = 8;
constexpr int RP = 1152;
constexpr int RPP = 288;

#define LAS __attribute__((address_space(3)))
typedef unsigned short bf16_t;
typedef short bf16x8 __attribute__((ext_vector_type(8)));
typedef float f32x4 __attribute__((ext_vector_type(4)));
typedef unsigned u32x4 __attribute__((ext_vector_type(4)));
typedef unsigned u32x2 __attribute__((ext_vector_type(2)));

__device__ __forceinline__ unsigned f2bf(float f) { unsigned u = __builtin_bit_cast(unsigned, f); return (u + 0x7fffu + ((u >> 16) & 1u)) >> 16; }
typedef float f32x2_c __attribute__((ext_vector_type(2))); typedef __bf16 bf16x2_c __attribute__((ext_vector_type(2)));
__device__ __forceinline__ unsigned pk2(float lo, float hi) { f32x2_c v = {lo, hi}; bf16x2_c b = __builtin_convertvector(v, bf16x2_c); return __builtin_bit_cast(unsigned, b); }
typedef _Float16 h16x2_c __attribute__((ext_vector_type(2)));
__device__ __forceinline__ unsigned pkh2(float lo, float hi) { unsigned a, b; asm("v_cvt_f16_f32 %0, %1" : "=v"(a) : "v"(lo)); asm("v_cvt_f16_f32 %0, %1" : "=v"(b) : "v"(hi));
    return (a & 0xffffu) | (b << 16); }
__device__ __forceinline__ f32x4 unpkh4(u32x2 w) {
    float a, b, c, d; const unsigned hx = w.x >> 16, hy = w.y >> 16;
    asm("v_cvt_f32_f16 %0, %1" : "=v"(a) : "v"(w.x)); asm("v_cvt_f32_f16 %0, %1" : "=v"(b) : "v"(hx));
    asm("v_cvt_f32_f16 %0, %1" : "=v"(c) : "v"(w.y)); asm("v_cvt_f32_f16 %0, %1" : "=v"(d) : "v"(hy));
    return (f32x4){a, b, c, d};
}
__device__ __forceinline__ float bf2f(unsigned short b) { return __builtin_bit_cast(float, (unsigned)b << 16); }

namespace pg8 {
constexpr int BM = 256, BK = 64, HALF = 128, HTB = HALF * BK * 2, STAGE_BYTES = 8 * HTB, NXCD = 8, WGM = 8;
__host__ __device__ __forceinline__ int lds_byte(int r, int c) { const int st = (r >> 4) * 2 + (c >> 5), rr = r & 15, cc = c & 31, ob = rr * 64 + cc * 2; return st * 1024 + (ob ^ (((ob >> 9) & 1) << 5)); }
__host__ __device__ __forceinline__ void stage_rc(int b, int& R, int& C) { const int st = b / 1024, sb = b % 1024, swz = sb ^ (((sb >> 9) & 1) << 5); R = (st >> 1) * 16 + swz / 64; C = (st & 1) * 32 + (swz % 64) / 2; }

struct Unit { int pm, pn; int kt0, nkt  ; int rng  ; int role  ; };
struct Gemm { const bf16_t* A; const bf16_t* Bt; int lda, ldb, K; size_t a_pn_step, b_unit_step, b_half_step; };

struct StaticOrder {
    int nM, nN, nwg, G, c;
    __host__ __device__ __forceinline__ void init(int M, int N, int G_, int c_) { nM = M / BM; nN = N / BM; nwg = nM * nN; G = G_; c = c_; }
    __host__ __device__ __forceinline__ bool next(int i, Unit& u) const {
        const long Lx = (long)i * G + c; if (Lx >= nwg) return false;
        int wgid = (int)Lx; { const int q = nwg / NXCD, r = nwg % NXCD, xcd = wgid % NXCD, off = wgid / NXCD; wgid = (xcd < r ? xcd * (q + 1) : r * (q + 1) + (xcd - r) * q) + off; }
        const int nig = WGM * nN, gid = wgid / nig, fm = gid * WGM, gsz = (nM - fm) < WGM ? (nM - fm) : WGM;
        u.pm = fm + ((wgid % nig) % gsz); u.pn = (wgid % nig) / gsz; u.kt0 = 0; u.nkt = 0; u.rng = 0; u.role = 0; return true;
    }
};


struct StreamOrder {
    int nN, nkt, nblk, r, s, e;
    int mode;
    __host__ __device__ __forceinline__ void init(int M, int N, int K, int G, int c, int mode_) { mode = mode_; const int nM = M / BM; nN = N / BM; nkt = K / BK; nblk = nM * nN / 16;
        const int x = c % 8, i = c / 8; r = (G == 256) ? (2 * x + (i & 1)) + 16 * (i >> 1) : c;
        const long q = (long)nM * nN * nkt / 4; s = 4 * (int)((long)r * q / G); e = 4 * (int)((long)(r + 1) * q / G); }
    __host__ __device__ __forceinline__ bool next(int i, Unit& u) const {
        const bool has_tail = (s % nkt) != 0;
        if (mode == 0) { if (i > 0 || !has_tail) return false; } else if (has_tail) ++i;
        int p = s; for (int k = 0; k < i; ++k) { const int ue = (p / nkt + 1) * nkt; p = ue < e ? ue : e; }
        if (p >= e) return false;
        const int ui = p / nkt, kt0 = p % nkt, ue = (ui + 1) * nkt, pe = ue < e ? ue : e;
        const int k = ui / nblk, j = ui % nblk, ncb = nN / 4, jb = j / ncb, jc = j % ncb;
        u.pm = 4 * jb + (k & 3); u.pn = 4 * jc + (k >> 2); u.kt0 = kt0; u.nkt = pe - p; u.rng = r; u.role = (kt0 == 0 && pe == ue) ? 0 : (kt0 > 0 ? 1 : 2);
        return true;
    }
};

template <class Epi, class Sched, bool ALIGN_EPI>
__device__ __forceinline__ void gemm_phase(LAS unsigned char* lds, const Gemm g, const Sched& S, const Epi& E) {
    int tid = threadIdx.x; asm volatile("" : "+v"(tid));
    const int wid = __builtin_amdgcn_readfirstlane(tid >> 6), lane = tid & 63, wr = wid >> 2, wc = wid & 3, fr = lane & 15, fq = lane >> 4;
    int K = g.K; asm volatile("" : "+s"(K));
    const int nt_full = K / BK;
    unsigned voffA[2], voffB[2];
#pragma unroll
    for (int i = 0; i < 2; ++i) { int R, C; stage_rc(tid * 16 + i * 8192, R, C); const int Rb = Epi::brow(R);
        voffA[i] = (unsigned)(R * g.lda + C) * 2u; voffB[i] = (unsigned)(Rb * g.ldb + C) * 2u; }
    const size_t kstep = (size_t)(BK * 2);
    const size_t hstepA = (size_t)HALF * g.lda * 2, tstepA = 2 * hstepA, hstepB = g.b_half_step;
    const unsigned ldsw = (unsigned)wid * 1024u;
    const int aoff = lds_byte(wr * 64 + fr, fq * 8), boff = lds_byte(wc * 32 + fr, fq * 8);
#define PG8_SA(b, h) (((b) * 2 + (h)) * HTB)
#define PG8_SB(b, h) ((4 + (b) * 2 + (h)) * HTB)
#define PG8_STAGE(bufoff, gbase, voff) do { const char* gb_ = (const char*)(gbase); asm volatile("" : "+s"(gb_)); _Pragma("unroll") for (int _i = 0; _i < 2; ++_i) \
        __builtin_amdgcn_global_load_lds((const unsigned*)(gb_ + (voff)[_i]), (LAS unsigned*)(lds + (bufoff) + ldsw + _i * 8192), 16, 0, 0); } while (0)
#define PG8_LDA(dst, b, h) do { _Pragma("unroll") for (int m = 0; m < 4; ++m) _Pragma("unroll") for (int k = 0; k < 2; ++k) dst[m][k] = *(const LAS bf16x8*)(lds + PG8_SA(b, h) + aoff + m * 2048 + k * 1024); } while (0)
#define PG8_LDB(dst, b, h) do { _Pragma("unroll") for (int n = 0; n < 2; ++n) _Pragma("unroll") for (int k = 0; k < 2; ++k) dst[n][k] = *(const LAS bf16x8*)(lds + PG8_SB(b, h) + boff + n * 2048 + k * 1024); } while (0)
#define PG8_MMA(ai, bj, At, Bt) do { __builtin_amdgcn_s_setprio(1); _Pragma("unroll") for (int m = 0; m < 4; ++m) _Pragma("unroll") for (int n = 0; n < 2; ++n) _Pragma("unroll") for (int k = 0; k < 2; ++k) \
        acc[ai][bj][m][n] = __builtin_amdgcn_mfma_f32_16x16x32_bf16(Bt[n][k], At[m][k], acc[ai][bj][m][n], 0, 0, 0); __builtin_amdgcn_s_setprio(0); } while (0)
#define PG8_ZERO_ACC() do { _Pragma("unroll") for (int a_ = 0; a_ < 2; ++a_) _Pragma("unroll") for (int b_ = 0; b_ < 2; ++b_) _Pragma("unroll") for (int m_ = 0; m_ < 4; ++m_) _Pragma("unroll") for (int n_ = 0; n_ < 2; ++n_) { \
        typedef unsigned long long u64x2_t __attribute__((ext_vector_type(2))); unsigned long long z0_, z1_; asm volatile("v_mov_b64 %0, 0\n\tv_mov_b64 %1, 0" : "=v"(z0_), "=v"(z1_)); \
        u64x2_t q_; q_.x = z0_; q_.y = z1_; acc[a_][b_][m_][n_] = __builtin_bit_cast(f32x4, q_); } } while (0)
#define PG8_WAIT_V(n) asm volatile("s_waitcnt vmcnt(" #n ")" ::: "memory")
#define PG8_WAIT_L(n) asm volatile("s_waitcnt lgkmcnt(" #n ")" ::: "memory")
#define PG8_BAR __builtin_amdgcn_s_barrier()
#define PG8_SCHED __builtin_amdgcn_sched_barrier(0)
    Unit cur, nxt; int ui = 0;
    if (!S.next(0, cur)) return;
    typedef int i32x4_t __attribute__((ext_vector_type(4))); typedef int i32x2_t __attribute__((ext_vector_type(2)));
    LAS int* stab = (LAS int*)(lds + STAGE_BYTES + 512);
    constexpr bool USE_TAB = __is_same(Sched, StaticOrder) && Epi::sched_tab;
    if constexpr (USE_TAB) { Unit tu; tu.pm = 0; tu.pn = 0; const bool ok = S.next(wid + 1, tu);
      if (lane == 0) *(LAS i32x2_t*)(stab + wid * 2) = (i32x2_t){ok ? tu.pm : -1, tu.pn};
      asm volatile("s_waitcnt lgkmcnt(0)" ::: "memory"); }
    f32x4 acc[2][2][4][2];
    PG8_ZERO_ACC();
    bf16x8 At[4][2], B0[2][2], B1[2][2];
    const char* cA = (const char*)g.A + (size_t)cur.pm * tstepA + (size_t)cur.pn * g.a_pn_step + (size_t)cur.kt0 * kstep; const char* cB = (const char*)g.Bt + (size_t)cur.pn * g.b_unit_step + (size_t)cur.kt0 * kstep;
    int nt = cur.nkt ? cur.nkt : nt_full;
    { int l2 = threadIdx.x; asm volatile("" : "+v"(l2)); l2 &= 63; E.prefetch(cur, wid, l2, 0); }
    PG8_STAGE(PG8_SB(0, 0), cB, voffB); PG8_STAGE(PG8_SB(0, 1), cB + hstepB, voffB); PG8_STAGE(PG8_SA(0, 0), cA, voffA); PG8_STAGE(PG8_SA(0, 1), cA + hstepA, voffA);
    if (wr == 1) PG8_BAR;
    PG8_WAIT_V(2); PG8_BAR;
    PG8_STAGE(PG8_SB(1, 0), cB + kstep, voffB); PG8_STAGE(PG8_SA(1, 0), cA + kstep, voffA); PG8_STAGE(PG8_SB(1, 1), cB + hstepB + kstep, voffB);
    PG8_WAIT_V(6); PG8_BAR;
    for (;;) {
        bool has_next;
        if constexpr (!USE_TAB) has_next = S.next(ui + 1, nxt);
        else if (ui >= 8) has_next = S.next(ui + 1, nxt);
        else { const i32x2_t v_ = *(const LAS i32x2_t*)(stab + ui * 2);
            nxt.pm = __builtin_amdgcn_readfirstlane(v_.x); nxt.pn = __builtin_amdgcn_readfirstlane(v_.y); nxt.kt0 = 0; nxt.nkt = 0; nxt.rng = 0; nxt.role = 0; has_next = nxt.pm >= 0; }
        const char* nA = has_next ? (const char*)g.A + (size_t)nxt.pm * tstepA + (size_t)nxt.pn * g.a_pn_step + (size_t)nxt.kt0 * kstep : cA; const char* nB = has_next ? (const char*)g.Bt + (size_t)nxt.pn * g.b_unit_step + (size_t)nxt.kt0 * kstep : cB;
        for (int t = 0; t < nt; t += 2) {
            asm volatile("" : "+v"(voffA[0]), "+v"(voffA[1]), "+v"(voffB[0]), "+v"(voffB[1]));
            const bool last = (t == nt - 2);
            const char* a1 = cA + (size_t)(t + 1) * kstep;
            const char* a2 = last ? nA : cA + (size_t)(t + 2) * kstep; const char* b2 = last ? nB : cB + (size_t)(t + 2) * kstep;
            const char* a3 = a2 + kstep; const char* b3 = b2 + kstep;
            PG8_LDB(B0, 0, 0); PG8_LDB(B1, 0, 1); PG8_SCHED; PG8_LDA(At, 0, 0); PG8_STAGE(PG8_SA(1, 1), a1 + hstepA, voffA);
            PG8_WAIT_V(8); PG8_WAIT_L(0); PG8_BAR; PG8_MMA(0, 0, At, B0); PG8_MMA(0, 1, At, B1); PG8_BAR; PG8_SCHED;
            PG8_LDA(At, 0, 1); PG8_STAGE(PG8_SB(0, 0), b2, voffB); PG8_STAGE(PG8_SB(0, 1), b2 + hstepB, voffB); PG8_STAGE(PG8_SA(0, 0), a2, voffA);
            PG8_WAIT_V(8); PG8_WAIT_L(0); PG8_BAR; PG8_MMA(1, 0, At, B0); PG8_MMA(1, 1, At, B1); PG8_BAR; PG8_SCHED;
            PG8_LDB(B0, 1, 0); PG8_LDB(B1, 1, 1); PG8_SCHED; PG8_LDA(At, 1, 0); PG8_STAGE(PG8_SA(0, 1), a2 + hstepA, voffA);
            PG8_WAIT_V(8); PG8_WAIT_L(0); PG8_BAR; PG8_MMA(0, 0, At, B0); PG8_MMA(0, 1, At, B1); PG8_BAR; PG8_SCHED;
            PG8_LDA(At, 1, 1); PG8_STAGE(PG8_SB(1, 0), b3, voffB); PG8_STAGE(PG8_SB(1, 1), b3 + hstepB, voffB); PG8_STAGE(PG8_SA(1, 0), a3, voffA);
            PG8_WAIT_V(8); PG8_WAIT_L(0); PG8_BAR; PG8_MMA(1, 0, At, B0); PG8_MMA(1, 1, At, B1); PG8_BAR; PG8_SCHED;
        }
        if constexpr (ALIGN_EPI) { if (wr == 0) PG8_BAR; }
        { int t2 = threadIdx.x; asm volatile("" : "+v"(t2));
          const int wid2 = __builtin_amdgcn_readfirstlane(t2 >> 6), lane2 = t2 & 63; E(acc, cur, wid2 >> 2, wid2 & 3, lane2 & 15, lane2 >> 4, ui & 1); }
        if (!has_next) break;
        PG8_ZERO_ACC();
        cur = nxt; cA = nA; cB = nB; ++ui; nt = cur.nkt ? cur.nkt : nt_full;
        { int l2 = threadIdx.x; asm volatile("" : "+v"(l2)); l2 &= 63; E.prefetch(cur, wid, l2, ui & 1); }
        if constexpr (ALIGN_EPI) { if (wr == 1) PG8_BAR; }
    }
    PG8_WAIT_V(0);
    if constexpr (!ALIGN_EPI) { if (wr == 0) PG8_BAR; }
    PG8_BAR;
#undef PG8_SA
#undef PG8_SB
#undef PG8_STAGE
#undef PG8_LDA
#undef PG8_LDB
#undef PG8_MMA
#undef PG8_ZERO_ACC
#undef PG8_WAIT_V
#undef PG8_WAIT_L
#undef PG8_BAR
#undef PG8_SCHED
}
}

namespace attn_body {
using s16x4 = __attribute__((ext_vector_type(4))) short;
using f32x16 = __attribute__((ext_vector_type(16))) float;
constexpr int DM = RP, KP = 256, NW = 8, QBLK = 32, QB = 256, KVBLK = 64;
__device__ __forceinline__ int crow(int r, int hi) { return (r & 3) + 8 * (r >> 2) + 4 * hi; }
#define SBAR() __builtin_amdgcn_sched_barrier(0)
constexpr int NSLOT = 3, SLOTB = 8192;
constexpr int LDS_K = 0, LDS_V = NSLOT * SLOTB, LDS_WS = 2 * NSLOT * SLOTB, LDS_OST = LDS_WS + NW * 64 * 4, LDS_QST = LDS_OST + NW * 4096, LDS_BYTES_A = LDS_QST + NW * 4096;
constexpr float C2 = 0.125f * 1.4426950408889634f;
__device__ __forceinline__ void glds16(const void* gsrc, unsigned lds_dst) { unsigned keep;
    asm volatile("s_mov_b32 %0, m0\n\ts_mov_b32 m0, %2\n\ts_nop 0\n\tglobal_load_lds_dwordx4 %1, off\n\ts_mov_b32 m0, %0" : "=&s"(keep) : "v"(gsrc), "s"(lds_dst) : "memory"); }
__device__ __forceinline__ void glds16s(const void* sbase, unsigned voff, unsigned lds_dst) { unsigned keep;
    asm volatile("s_mov_b32 %0, m0\n\ts_mov_b32 m0, %3\n\ts_nop 0\n\tglobal_load_lds_dwordx4 %1, %2\n\ts_mov_b32 m0, %0" : "=&s"(keep) : "v"(voff), "s"(sbase), "s"(lds_dst) : "memory"); }
typedef float f32x2_t __attribute__((ext_vector_type(2))); typedef __bf16 bf16x2_t __attribute__((ext_vector_type(2)));
__device__ __forceinline__ unsigned cvtpk_s(float lo, float hi) { f32x2_t v = {lo, hi}; bf16x2_t b = __builtin_convertvector(v, bf16x2_t); return __builtin_bit_cast(unsigned, b); }
#define WAIT_BAR(N) asm volatile("s_waitcnt vmcnt(" #N ") lgkmcnt(0)\n\ts_barrier" ::: "memory")
__device__ __forceinline__ void qkt(f32x16& p0, f32x16& p1, const char* Kslot, const bf16x8* qr, const f32x16& negm, int r32, int hi) {
    const int kb0 = r32 * 128 + ((hi ^ ((r32 >> 1) & 7)) * 16);
#pragma unroll
    for (int d0 = 0; d0 < 4; ++d0) {
        const bf16x8 b0 = *reinterpret_cast<const bf16x8*>(Kslot + (kb0 ^ (32 * d0)));
        const bf16x8 b1 = *reinterpret_cast<const bf16x8*>(Kslot + (kb0 ^ (32 * d0)) + 4096);
        if (d0 == 0) { p0 = __builtin_amdgcn_mfma_f32_32x32x16_bf16(b0, qr[0], negm, 0, 0, 0); p1 = __builtin_amdgcn_mfma_f32_32x32x16_bf16(b1, qr[0], negm, 0, 0, 0); }
        else { p0 = __builtin_amdgcn_mfma_f32_32x32x16_bf16(b0, qr[d0], p0, 0, 0, 0); p1 = __builtin_amdgcn_mfma_f32_32x32x16_bf16(b1, qr[d0], p1, 0, 0, 0); } }
}
typedef __attribute__((address_space(3))) const char* lds_cptr;
typedef short v4i16_t __attribute__((ext_vector_type(4)));
#define KLD(p) (*(const __attribute__((address_space(3))) bf16x8*)(p))
__device__ __forceinline__ void kload2(bf16x8* kf, lds_cptr kbase, int kb0, int slot, int j) { const lds_cptr kp = kbase + ((kb0 ^ (32 * j)) + slot); kf[2 * j] = KLD(kp); kf[2 * j + 1] = KLD(kp + 4096); }
__device__ __forceinline__ void kload8(bf16x8* kf, lds_cptr kbase, int kb0, int slot) { kload2(kf, kbase, kb0, slot, 0); kload2(kf, kbase, kb0, slot, 1); kload2(kf, kbase, kb0, slot, 2); kload2(kf, kbase, kb0, slot, 3); }
__device__ __forceinline__ s16x4 vtr(lds_cptr p) { return __builtin_bit_cast(s16x4, __builtin_amdgcn_ds_read_tr16_b64_v4i16((__attribute__((address_space(3))) v4i16_t*)p)); }
__device__ __forceinline__ void pv(f32x16* o, int vb, bf16x8 pa0, bf16x8 pa1, bf16x8 pa2, bf16x8 pa3) {
#pragma unroll
    for (int d0 = 0; d0 < 2; ++d0) { s16x4 lo[4], hi[4];
#pragma unroll
        for (int ks = 0; ks < 4; ++ks) {
            asm volatile("ds_read_b64_tr_b16 %0,%1 offset:%c2" : "=&v"(lo[ks]) : "v"(vb), "i"(d0 * 4096 + ks * 1024) : "memory");
            asm volatile("ds_read_b64_tr_b16 %0,%1 offset:%c2" : "=&v"(hi[ks]) : "v"(vb), "i"(d0 * 4096 + ks * 1024 + 512) : "memory"); }
        asm volatile("s_waitcnt lgkmcnt(0)" ::: "memory"); SBAR();
#define PK(k) (bf16x8){lo[k][0], lo[k][1], lo[k][2], lo[k][3], hi[k][0], hi[k][1], hi[k][2], hi[k][3]}
        o[d0] = __builtin_amdgcn_mfma_f32_32x32x16_bf16(pa0, PK(0), o[d0], 0, 0, 0);
        o[d0] = __builtin_amdgcn_mfma_f32_32x32x16_bf16(pa1, PK(1), o[d0], 0, 0, 0);
        o[d0] = __builtin_amdgcn_mfma_f32_32x32x16_bf16(pa2, PK(2), o[d0], 0, 0, 0);
        o[d0] = __builtin_amdgcn_mfma_f32_32x32x16_bf16(pa3, PK(3), o[d0], 0, 0, 0);
#undef PK
    }
}
__device__ __forceinline__ void attn_unit(int qrow0, int h, int nh, int krow0, int kvh, int NT, float m2, bf16_t* Q, const bf16_t* __restrict__ K, const bf16_t* __restrict__ V, char* shm) {
    int tid = threadIdx.x; asm volatile("" : "+v"(tid));
    const int lane = tid & 63, r32 = lane & 31, hi = lane >> 5; const int wid = __builtin_amdgcn_readfirstlane(tid >> 6);
    const bf16_t* Qw = Q + (size_t)(qrow0 + wid * QBLK) * DM + h * 64;
    const bf16_t* Kh = K + (size_t)krow0 * KP + kvh * 64; const bf16_t* Vh = V + (size_t)krow0 * KP + kvh * 64;
    const unsigned lds0 = (unsigned)(uintptr_t)shm;
    float* wsf = (float*)(shm + LDS_WS) + wid * 64;
    const int kkey = 8 * wid + (lane >> 3);
    const unsigned kvoff = (unsigned)(kkey * KP + (((lane & 7) ^ ((kkey >> 1) & 7)) * 8)) * 2u;
    const unsigned vvoff = (unsigned)((16 * (wid & 3) + (lane >> 2)) * KP + (wid >> 2) * 32 + (lane & 3) * 8) * 2u;
    const unsigned kdst = lds0 + LDS_K + wid * 1024, vdst = lds0 + LDS_V + wid * 1024;
#define DMA_K(t, slot) glds16s(Kh + (long)(t) * KVBLK * KP, kvoff, (unsigned)__builtin_amdgcn_readfirstlane(kdst + (slot)))
#define DMA_V(t, slot) glds16s(Vh + (long)(t) * KVBLK * KP, vvoff, (unsigned)__builtin_amdgcn_readfirstlane(vdst + (slot)))
    const int TT = nh * NT; int kt3 = 4 % NT, vt1 = 2 % NT;
    const unsigned qst = lds0 + LDS_QST + wid * 4096;
#define DMA_Q(hh) do { const bf16_t* qn_ = Q + (size_t)(qrow0 + wid * QBLK) * DM + (hh) * 64 + (long)r32 * DM + hi * 8; _Pragma("unroll") for (int d0 = 0; d0 < 4; ++d0) glds16(qn_ + d0 * 16, (unsigned)__builtin_amdgcn_readfirstlane(qst + d0 * 1024)); } while (0)
    const int vb0 = (int)(lds0 + LDS_V) + ((lane >> 4) & 1) * 32 + (lane & 3) * 8 + (4 * hi + ((lane & 15) >> 2)) * 64;
    const char* Kbase = shm + LDS_K; bf16x8 kf[8];
    const lds_cptr shm3 = (lds_cptr)shm; const lds_cptr kbase = shm3 + LDS_K; const int kb0 = r32 * 128 + ((hi ^ ((r32 >> 1) & 7)) * 16); const lds_cptr vp0 = shm3 + LDS_V + ((lane >> 4) & 1) * 32 + (lane & 3) * 8 + (4 * hi + ((lane & 15) >> 2)) * 64;
    DMA_K(0, 0); DMA_V(0, 0); DMA_K(1, SLOTB);
    bf16x8 qr[4];
#pragma unroll
    for (int d0 = 0; d0 < 4; ++d0) qr[d0] = *reinterpret_cast<const bf16x8*>(&Qw[(long)r32 * DM + d0 * 16 + hi * 8]);
    float l_reg = 0.f; f32x16 o[2]; o[0] = f32x16{}; o[1] = f32x16{}; f32x16 negm;
#pragma unroll
    for (int r = 0; r < 16; ++r) negm[r] = -m2;
    asm volatile("" : "+v"(negm));
    f32x16 pA0, pA1, pB0, pB1;
    int sl_prev = 0, sl_cur = 0, sl_next = SLOTB;
#define ROT() do { sl_prev = sl_cur; sl_cur = sl_next; sl_next = (sl_next == (NSLOT - 1) * SLOTB) ? 0 : sl_next + SLOTB; } while (0)
    if (nh > 1) DMA_Q(h + 1);
    DMA_K(2, 2 * SLOTB);
    WAIT_BAR(3);
    qkt(pA0, pA1, Kbase, qr, negm, r32, hi);
#pragma unroll
    for (int r = 0; r < 16; ++r) { pA0[r] = __builtin_amdgcn_exp2f(pA0[r]); pA1[r] = __builtin_amdgcn_exp2f(pA1[r]); }
    WAIT_BAR(0);
    DMA_K(3, 0); DMA_V(1, SLOTB);
    ROT();
    kload8(kf, kbase, kb0, sl_cur);
    WAIT_BAR(2);
    s16x4 vlo[8], vhi[8]; u32x4 pw0, pw1, pw2, pw3;
#define PKW(P, B) cvtpk_s(P[B], P[B + 1])
#define PAF(k) __builtin_bit_cast(bf16x8, pw##k)
#define VFR(i) (bf16x8){vlo[i][0], vlo[i][1], vlo[i][2], vlo[i][3], vhi[i][0], vhi[i][1], vhi[i][2], vhi[i][3]}
#define PIN(x) asm volatile("" : "+v"(x))
#define GAPA(MF, A0, A1, A2, A3, W0, W1, PW) do { MF; sacc += A0; sacc += A1; sacc += A2; sacc += A3; PIN(sacc); W0; W1; PIN(PW); SBAR(); } while (0)
#define GAPA2(MF, A0, A1, W0, W1, PW) do { MF; sacc += A0; sacc += A1; PIN(sacc); W0; W1; PIN(PW); SBAR(); } while (0)
#define EX(v) __builtin_amdgcn_exp2f(v)
#define GAPB(MF, X, B) do { MF; X[B] = EX(X[B]); X[B + 1] = EX(X[B + 1]); X[B + 2] = EX(X[B + 2]); X[B + 3] = EX(X[B + 3]); PIN(X); SBAR(); } while (0)
#define VRD(i) do { vlo[i] = vtr(vp_ + (((i) >> 2) * 4096 + ((i) & 3) * 1024)); vhi[i] = vtr(vp_ + (((i) >> 2) * 4096 + ((i) & 3) * 1024 + 512)); } while (0)
#define KRD(G, j) do { if (G) { kload2(kf, kbase, kb0, sl_next, j); SBAR(); } } while (0)
#define MF32(a, b, c) __builtin_amdgcn_mfma_f32_32x32x16_bf16(a, b, c, 0, 0, 0)
#define STEP(C0, C1, P0, P1, t, GK, GV, GL) do { SBAR(); \
    const lds_cptr vp_ = vp0 + sl_prev; \
    VRD(0); SBAR(); float sacc = (P0[0] + P0[1]); \
    GAPA(C0 = MF32(kf[0], qr[0], negm), P0[2], P0[3], P0[4], P0[5],     pw0[0] = PKW(P0, 0), pw0[1] = PKW(P0, 2), pw0); \
    VRD(4); SBAR(); GAPA(C1 = MF32(kf[1], qr[0], negm), P0[6], P0[7], P0[8], P0[9],     pw0[2] = PKW(P0, 4), pw0[3] = PKW(P0, 6), pw0); \
    VRD(1); SBAR(); GAPA(C0 = MF32(kf[2], qr[1], C0),   P0[10], P0[11], P0[12], P0[13], pw1[0] = PKW(P0, 8), pw1[1] = PKW(P0, 10), pw1); \
    VRD(5); SBAR(); GAPA(C1 = MF32(kf[3], qr[1], C1),   P0[14], P0[15], P1[0], P1[1],   pw1[2] = PKW(P0, 12), pw1[3] = PKW(P0, 14), pw1); \
    VRD(2); SBAR(); GAPA(C0 = MF32(kf[4], qr[2], C0),   P1[2], P1[3], P1[4], P1[5],     pw2[0] = PKW(P1, 0), pw2[1] = PKW(P1, 2), pw2); \
    VRD(6); SBAR(); GAPA(C1 = MF32(kf[5], qr[2], C1),   P1[6], P1[7], P1[8], P1[9],     pw2[2] = PKW(P1, 4), pw2[3] = PKW(P1, 6), pw2); \
    VRD(3); SBAR(); GAPA(C0 = MF32(kf[6], qr[3], C0),   P1[10], P1[11], P1[12], P1[13], pw3[0] = PKW(P1, 8), pw3[1] = PKW(P1, 10), pw3); \
    VRD(7); SBAR(); GAPA2(C1 = MF32(kf[7], qr[3], C1),  P1[14], P1[15],                 pw3[2] = PKW(P1, 12), pw3[3] = PKW(P1, 14), pw3); \
    l_reg += sacc; \
    if (GK) { DMA_K(kt3, sl_cur); } if (GV) { DMA_V(vt1, sl_next); } kt3 = (kt3 + 1 == NT) ? 0 : kt3 + 1; vt1 = (vt1 + 1 == NT) ? 0 : vt1 + 1; \
    SBAR(); \
    GAPB(o[0] = MF32(PAF(0), VFR(0), o[0]), C0, 0); \
    GAPB(o[1] = MF32(PAF(0), VFR(4), o[1]), C0, 4); \
    KRD(GL, 0); GAPB(o[0] = MF32(PAF(1), VFR(1), o[0]), C0, 8); \
    KRD(GL, 1); GAPB(o[1] = MF32(PAF(1), VFR(5), o[1]), C0, 12); \
    KRD(GL, 2); GAPB(o[0] = MF32(PAF(2), VFR(2), o[0]), C1, 0); \
    KRD(GL, 3); GAPB(o[1] = MF32(PAF(2), VFR(6), o[1]), C1, 4); \
    GAPB(o[0] = MF32(PAF(3), VFR(3), o[0]), C1, 8); \
    GAPB(o[1] = MF32(PAF(3), VFR(7), o[1]), C1, 12); \
    } while (0)
#define FINALIZE(hh) do { \
    { auto rr = __builtin_amdgcn_permlane32_swap(__float_as_uint(l_reg), __float_as_uint(l_reg), false, false); l_reg = __uint_as_float(rr[0]) + __uint_as_float(rr[1]); } \
    if (hi == 0) wsf[32 + r32] = l_reg; asm volatile("s_waitcnt lgkmcnt(0)" ::: "memory"); \
    float rli[16]; \
    _Pragma("unroll") for (int r = 0; r < 16; ++r) rli[r] = __builtin_amdgcn_rcpf(wsf[32 + crow(r, hi)]); \
    bf16_t* Ow = Q + (size_t)(qrow0 + wid * QBLK) * DM + (hh) * 64; \
    { bf16_t* stg = (bf16_t*)(shm + LDS_OST) + wid * 2048; \
      _Pragma("unroll") for (int r = 0; r < 16; ++r) { const int orow = crow(r, hi); \
          _Pragma("unroll") for (int d0 = 0; d0 < 2; ++d0) stg[orow * 64 + d0 * 32 + r32] = (bf16_t)f2bf(o[d0][r] * rli[r]); } \
      asm volatile("s_waitcnt lgkmcnt(0)" ::: "memory"); \
      _Pragma("unroll") for (int i = 0; i < 4; ++i) { const int row = i * 8 + (lane >> 3), ch = lane & 7; const u32x4 v = *(const u32x4*)(stg + row * 64 + ch * 8); *(u32x4*)(Ow + (long)row * DM + ch * 8) = v; } \
      asm volatile("s_waitcnt lgkmcnt(0)" ::: "memory"); } } while (0)
    int t = 1, hcur = h;
    for (int m = 0; m < nh; ++m) {
        const bool lasth = (m == nh - 1); const int lim = lasth ? TT - 5 : (m + 1) * NT - 1;
        for (; t < lim; t += 2) {
            STEP(pB0, pB1, pA0, pA1, t, true, true, true);     WAIT_BAR(2); ROT();
            STEP(pA0, pA1, pB0, pB1, t + 1, true, true, true); WAIT_BAR(2); ROT();
        }
        if (!lasth) {
            STEP(pB0, pB1, pA0, pA1, t, true, true, true);     WAIT_BAR(2); ROT();
#pragma unroll
            for (int d0 = 0; d0 < 4; ++d0) qr[d0] = *(const __attribute__((address_space(3))) bf16x8*)((lds_cptr)shm3 + LDS_QST + wid * 4096 + d0 * 1024 + lane * 16);
            STEP(pA0, pA1, pB0, pB1, t + 1, true, true, true); WAIT_BAR(2); ROT();
            FINALIZE(hcur);
            o[0] = f32x16{}; o[1] = f32x16{}; l_reg = 0.f;
            ++hcur; t += 2;
            if (hcur + 1 < h + nh) DMA_Q(hcur + 1);
        }
    }
#define ENDW(tt) do { if ((tt) + 3 < TT) { WAIT_BAR(2); } else if ((tt) + 2 < TT) { WAIT_BAR(1); } else { WAIT_BAR(0); } } while (0)
    for (; t + 1 < TT; t += 2) {
        STEP(pB0, pB1, pA0, pA1, t, (t + 3 < TT), (t + 1 < TT), (t + 1 < TT));         ENDW(t);     ROT();
        STEP(pA0, pA1, pB0, pB1, t + 1, (t + 4 < TT), (t + 2 < TT), (t + 2 < TT));     ENDW(t + 1); ROT();
    }
    STEP(pB0, pB1, pA0, pA1, TT - 1, false, false, false);
    { float sacc = pB0[0] + pB0[1];
#pragma unroll
      for (int r = 2; r < 16; ++r) sacc += pB0[r];
#pragma unroll
      for (int r = 0; r < 16; ++r) sacc += pB1[r];
      l_reg += sacc;
      pw0 = (u32x4){PKW(pB0, 0), PKW(pB0, 2), PKW(pB0, 4), PKW(pB0, 6)}; pw1 = (u32x4){PKW(pB0, 8), PKW(pB0, 10), PKW(pB0, 12), PKW(pB0, 14)}; pw2 = (u32x4){PKW(pB1, 0), PKW(pB1, 2), PKW(pB1, 4), PKW(pB1, 6)}; pw3 = (u32x4){PKW(pB1, 8), PKW(pB1, 10), PKW(pB1, 12), PKW(pB1, 14)};
      SBAR(); pv(o, vb0 + sl_cur, PAF(0), PAF(1), PAF(2), PAF(3)); }
#undef PKW
#undef PAF
#undef VFR
#undef PIN
#undef GAPA
#undef GAPA2
#undef GAPB
#undef EX
#undef VRD
#undef KRD
#undef STEP
#undef ENDW
#undef MF32
    FINALIZE(hcur);
    asm volatile("s_waitcnt lgkmcnt(0)\n\ts_barrier" ::: "memory");
#undef FINALIZE
#undef DMA_K
#undef DMA_V
#undef ROT
}
#undef SBAR
#undef WAIT_BAR
}

constexpr size_t MiB = 1u << 20;
constexpr size_t WS_CTL = 0, CTL_ZERO_BYTES = 640 * 1024;
constexpr size_t WS_SFLAG = 64 * 1024, SFLAG_PHASE = 272 * 256, WS_ZERO = 32 * 1024  ;
constexpr size_t WS_MOD = 1 * MiB;
constexpr size_t WS_ROPE = 1 * MiB + 512 * 1024;
constexpr size_t WS_WQKV = 2 * MiB;
constexpr size_t WS_WO = 9 * MiB;
constexpr size_t WS_WPOOL = 14 * MiB;
constexpr size_t WS_WIN = 15 * MiB;
constexpr size_t WS_WOUT = 20 * MiB;
constexpr size_t WS_WUP = 23 * MiB;
constexpr size_t WS_WDN = 73 * MiB;
constexpr size_t WS_H = 95 * MiB;
constexpr size_t WS_BIG1 = 134 * MiB;
constexpr size_t WS_BIG2 = 230 * MiB;
constexpr size_t WS_PARTX = 302 * MiB;
constexpr size_t WS_BIASW = 303 * MiB;
constexpr size_t BW_QKV = 0, BW_WIN = 2 * 5 * 1536, BW_UP = BW_WIN + 5 * 2048;
constexpr size_t BW_CONVP = BW_UP + 4 * 5 * 5632  , BW_GAINP = BW_CONVP + 4 * 22 * 1024  , BW_END = BW_GAINP + 512;
static_assert(BW_END * 4 <= MiB, "BIASW region");
constexpr size_t WS_XB = 304 * MiB;
constexpr size_t WS_END = 343 * MiB;
constexpr size_t WS_SU = WS_BIG1, WS_SV = WS_BIG1 + 40 * MiB, WS_SPART = WS_BIG1 + 80 * MiB;
constexpr size_t WS_EDGE = WS_BIG2 + 60 * MiB;
constexpr size_t WS_Q = WS_BIG2, WS_K = WS_BIG2 + 40 * MiB, WS_V = WS_K + 10 * MiB;
static_assert((size_t)NTOK * FF * 2 <= 96 * MiB && (size_t)NTOK * RP * 2 <= 40 * MiB && WS_XB + (size_t)NTOK * RP * 2 <= WS_END && WS_H + (size_t)NTOK * RP * 2 <= WS_BIG1 && WS_WUP + (size_t)4 * FF2 * RP * 2 <= WS_WDN, "ws map");

constexpr int RING_BYTES = 131072, LDSCTL_OFF = RING_BYTES, MISC_OFF = LDSCTL_OFF + 320, XB_OFF = LDSCTL_OFF + 1024  ,
              PRM_OFF = XB_OFF + 12288  , PRM_STRIDE = 9728,
              ROPE_OFF = XB_OFF + 2048  , LDS_BYTES = PRM_OFF + 2 * PRM_STRIDE;
static_assert(LDS_BYTES <= 163840, "LDS");
static_assert(pg8::STAGE_BYTES == LDSCTL_OFF && MISC_OFF + 64 <= LDSCTL_OFF + 512 && LDSCTL_OFF + 768 <= XB_OFF, "scheduler table [LDSCTL_OFF + 512, + 768)");

#define XB_TMO      128
#define XB_XCNT(j)  (256  + 64 * (j))
#define XB_XSUB(j)  (1280 + 64 * (j))
#define XB_XGEN(j)  (2304 + 64 * (j))
#define XB_TOP      3328
#define XB_TOPGEN   3392
#define XCD_BAR_WORDS 3456
#define XB_SPIN_CAP (1u << 18)
__device__ __forceinline__ unsigned xb_ld(unsigned* p)              { return __hip_atomic_load(p, __ATOMIC_RELAXED, __HIP_MEMORY_SCOPE_AGENT); }
__device__ __forceinline__ unsigned xb_add(unsigned* p, unsigned v) { return __hip_atomic_fetch_add(p, v, __ATOMIC_RELAXED, __HIP_MEMORY_SCOPE_AGENT); }
__device__ __forceinline__ unsigned xb_xcc_id() { return (unsigned)__builtin_amdgcn_s_getreg((3 << 11) | 20) & 0xFu; }
#define XB_SPIN(cond, bar) do { unsigned _sp = 0; while (cond) { __builtin_amdgcn_s_sleep(1); \
    if ((++_sp & 255u) == 0u) { if (xb_ld(&(bar)[XB_TMO])) break; if (_sp > XB_SPIN_CAP) { atomicAdd(&(bar)[XB_TMO], 1u); break; } } } } while (0)
struct XcdBarrier { unsigned* bar; unsigned x; volatile LAS unsigned* st; };
__device__ __forceinline__ XcdBarrier xcd_barrier_post(unsigned* bar, volatile LAS unsigned* st) {
    XcdBarrier b; b.bar = bar; b.x = xb_xcc_id(); b.st = st;
    if (threadIdx.x == 0) (void)xb_add(&bar[XB_XCNT(b.x)], 1u);
    return b;
}
__device__ __forceinline__ void xcd_barrier_complete(unsigned* bar, unsigned x, unsigned& nloc, unsigned& nx) {
    const unsigned G = gridDim.x * gridDim.y * gridDim.z;
    unsigned sum, cnt, mine, sp = 0u;
    for (;;) {
        sum = 0u; cnt = 0u; mine = 0u;
#pragma unroll
        for (unsigned j = 0; j < 16; ++j) { const unsigned c = xb_ld(&bar[XB_XCNT(j)]); sum += c; cnt += (c > 0u) ? 1u : 0u; mine = (j == x) ? c : mine; }
        if (sum == G) break;
        __builtin_amdgcn_s_sleep(1);
        if ((++sp & 255u) == 0u) { if (xb_ld(&bar[XB_TMO])) break; if (sp > XB_SPIN_CAP) { atomicAdd(&bar[XB_TMO], 1u); break; } }
    }
    nloc = mine > 0u ? mine : 1u; nx = cnt > 0u ? cnt : 1u;
}
__device__ __forceinline__ void xcd_barrier(const XcdBarrier& b) {
    asm volatile("s_waitcnt vmcnt(0)" ::: "memory");
    __syncthreads();
    if (threadIdx.x == 0) {
        unsigned long long bar_u = (unsigned long long)b.bar; unsigned blo = __builtin_amdgcn_readfirstlane((unsigned)bar_u), bhi = __builtin_amdgcn_readfirstlane((unsigned)(bar_u >> 32));
        asm volatile("" : "+s"(blo), "+s"(bhi)); unsigned* bar = (unsigned*)(((unsigned long long)bhi << 32) | blo); unsigned bx = __builtin_amdgcn_readfirstlane(b.x); asm volatile("" : "+s"(bx));
        __builtin_amdgcn_s_waitcnt(0);
        unsigned nloc = b.st[0], nx = b.st[1];
        if (nloc == 0u) { xcd_barrier_complete(bar, bx, nloc, nx); b.st[0] = nloc; b.st[1] = nx; }
        const unsigned old = xb_add(&bar[XB_XSUB(bx)], 1u);
        const unsigned gen = old / nloc;
        if (old + 1u == (gen + 1u) * nloc) {
            __builtin_amdgcn_fence(__ATOMIC_RELEASE, "agent");
            asm volatile("s_waitcnt vmcnt(0)" ::: "memory");
            const unsigned og = xb_add(&bar[XB_TOP], 1u);
            const unsigned tg = og / nx;
            if (og + 1u == (tg + 1u) * nx) xb_add(&bar[XB_TOPGEN], 1u);
            else XB_SPIN(xb_ld(&bar[XB_TOPGEN]) == tg, bar);
            __builtin_amdgcn_fence(__ATOMIC_ACQUIRE, "agent");
            xb_add(&bar[XB_XGEN(bx)], 1u);
            asm volatile("s_waitcnt vmcnt(0)" ::: "memory");
        } else {
            XB_SPIN(xb_ld(&bar[XB_XGEN(bx)]) == gen, bar);
            __builtin_amdgcn_fence(__ATOMIC_ACQUIRE, "agent");
            asm volatile("s_waitcnt vmcnt(0)" ::: "memory");
        }
    }
    __syncthreads();
}

struct Params { const float* in[24]; float* out; unsigned char* ws; };
enum { I_X = 0, I_C, I_CTX, I_CCTX, I_ADAW, I_ADAB, I_NORMW, I_WQKV, I_QG, I_KG, I_WO, I_POOLW, I_POOLB, I_POOLS, I_SWIN, I_SVG, I_SWS, I_SBS, I_SWOUT, I_WUP, I_CONVW, I_CONVB, I_WDN, I_FNORM };

struct Frame {
    unsigned char* ws; float* X;
    LAS unsigned char* lds3;
    float* lds;
};
__device__ __forceinline__ const float* inp(const Params& p, int k) { asm volatile("" : "+s"(k)); return p.in[k]; }
#define IN(k) inp(p, (k))
#define PHASE_IDS int tid = threadIdx.x; asm volatile("" : "+v"(tid)); const int lane = tid & 63, wave = __builtin_amdgcn_readfirstlane(tid >> 6); int bid = blockIdx.x; asm volatile("" : "+s"(bid)); const int G = gridDim.x; (void)lane; (void)wave; (void)bid; (void)G;
__device__ __forceinline__ unsigned char* wsp(unsigned char* ws, unsigned off) { asm volatile("" : "+s"(off)); return ws + off; }
#define WSP(T, off) ((T*)wsp(F.ws, (unsigned)(off)))

__device__ __forceinline__ float wave_sum(float v) {
#pragma unroll
    for (int o = 32; o > 0; o >>= 1) v += __shfl_xor(v, o);
    return v;
}
__device__ __forceinline__ int vidx(int r) { return r < NLAT ? r / L : 4; }
__device__ __forceinline__ float silu_f(float x) { return x / (1.f + expf(-x)); }


__device__ __forceinline__ void dma1k(const void* src, LAS unsigned char* dst, int lane) {
    __builtin_amdgcn_global_load_lds((const unsigned*)((const char*)src + lane * 16), (LAS unsigned*)dst, 16, 0, 0);
}
__device__ __forceinline__ void epi_sync() { asm volatile("s_waitcnt vmcnt(0) lgkmcnt(0)" ::: "memory"); __builtin_amdgcn_s_barrier(); asm volatile("" ::: "memory"); }
__device__ __forceinline__ void row_rs(const LAS float* prm, int rl_base, float (&rs)[2][4]) {
#pragma unroll
    for (int ai = 0; ai < 2; ++ai)
#pragma unroll
        for (int m = 0; m < 4; ++m) { const f32x4 q = *(const LAS f32x4*)(prm + (rl_base + ai * 128 + m * 16) * 4); rs[ai][m] = rsqrtf(((q[0] + q[1]) + (q[2] + q[3])) * (1.f / D) + EPS); }
}
template <bool POOL, bool FINM = false>
struct EpiResid {
    static constexpr bool sched_tab = true;
    static __host__ __device__ __forceinline__ int brow(int R) { const int rho = R & 31, n = rho >> 4, i = rho & 15; return (R & ~31) + 8 * (i >> 2) + 4 * n + (i & 3); }
    bf16_t* X  ; const float* mod_layer; int part; const float* bias; const float* scale;
    bf16_t* Hn; float* PARTX; const float* nwn; const float* modn; int partn; LAS float* sred  ; LAS float* prm;
    static constexpr int FIN_TAG = 99;
    __device__ __forceinline__ void prefetch(const pg8::Unit& u, int wid, int lane, int pbuf) const {
        const int rt = u.pm * 256, v = rt >= NLAT ? 4 : rt / L; const unsigned c = u.pn * 256; LAS unsigned char* pb = (LAS unsigned char*)prm + pbuf * PRM_STRIDE;
        if (wid == 0) dma1k(mod_layer + ((size_t)v * 6 + part) * D + c, pb, lane);
        if (Hn != nullptr) { if (wid == 1) dma1k(nwn + c, pb + 1024, lane); if (wid == 2) dma1k(modn + ((size_t)v * 6 + partn) * D + c, pb + 2048, lane); }
        if (POOL) { if (wid == 3) dma1k(scale + c, pb + 3072, lane); if (wid == 4) dma1k(bias + c, pb + 4096, lane); }
    }
    __device__ __forceinline__ void operator()(const f32x4 (&acc)[2][2][4][2], const pg8::Unit& u, int wr, int wc, int fr, int fq, int pbuf) const {
        const LAS float* prm = this->prm + pbuf * (PRM_STRIDE / 4);
        const int rt = u.pm * 256; const bool isctx = rt >= NLAT; const int v = isctx ? 4 : rt / L;
        const bf16_t* src = X + (size_t)rt * RP; bf16_t* dst = X + (size_t)rt * RP;
        const int tid = (wr * 4 + wc) * 64 + fq * 16 + fr;
        const bool next = Hn != nullptr, fin = FINM && !next && partn == FIN_TAG, need_ss = next || fin;
        const int colu = wc * 32 + 8 * fq, col0 = u.pn * 256 + colu;
#define RES_LOAD(XV, g_) do { const int c_ = col0 + ((g_) >> 1) * 128; _Pragma("unroll") for (int m = 0; m < 4; ++m) \
            XV[m] = *(const u32x4*)(src + (unsigned)((wr * 64 + fr + ((g_) & 1) * 128 + m * 16) * RP + c_)); } while (0)
        u32x4 xA[4], xB[4];
        RES_LOAD(xA, 0); RES_LOAD(xB, 1);
        float ss[2][4];
#pragma unroll
        for (int ai = 0; ai < 2; ++ai)
#pragma unroll
            for (int m = 0; m < 4; ++m) ss[ai][m] = 0.f;
#define RES_PROC(XV, g_) do { constexpr int bj_ = (g_) >> 1, ai = (g_) & 1; const int cu = colu + bj_ * 128, c = col0 + bj_ * 128; \
            f32x4 gv0 = *(const LAS f32x4*)(prm + cu), gv1 = *(const LAS f32x4*)(prm + cu + 4), ga0, ga1, gn0, gn1; \
            if (POOL) { gv0 = gv0 * *(const LAS f32x4*)(prm + 768 + cu); gv1 = gv1 * *(const LAS f32x4*)(prm + 768 + cu + 4); ga0 = gv0 * *(const LAS f32x4*)(prm + 1024 + cu); ga1 = gv1 * *(const LAS f32x4*)(prm + 1024 + cu + 4); } \
            if (next) { gn0 = *(const LAS f32x4*)(prm + 256 + cu) * (*(const LAS f32x4*)(prm + 512 + cu) + 1.f); gn1 = *(const LAS f32x4*)(prm + 256 + cu + 4) * (*(const LAS f32x4*)(prm + 512 + cu + 4) + 1.f); } \
            _Pragma("unroll") for (int m = 0; m < 4; ++m) { const int rl = wr * 64 + fr + ai * 128 + m * 16; const unsigned off = (unsigned)rl * RP + c; \
                const u32x4 xw_ = XV[m]; const f32x4 xo0 = unpkh4((u32x2){xw_.x, xw_.y}), xo1 = unpkh4((u32x2){xw_.z, xw_.w}); \
                f32x4 xn0 = xo0 + gv0 * acc[ai][bj_][m][0], xn1 = xo1 + gv1 * acc[ai][bj_][m][1]; if (POOL) { xn0 = xn0 + ga0; xn1 = xn1 + ga1; } \
                { u32x4 xw; xw.x = pkh2(xn0[0], xn0[1]); xw.y = pkh2(xn0[2], xn0[3]); xw.z = pkh2(xn1[0], xn1[1]); xw.w = pkh2(xn1[2], xn1[3]); *(u32x4*)(dst + off) = xw; } \
                if (need_ss) ss[ai][m] += ((xn0[0] * xn0[0] + xn0[1] * xn0[1]) + (xn0[2] * xn0[2] + xn0[3] * xn0[3])) + ((xn1[0] * xn1[0] + xn1[1] * xn1[1]) + (xn1[2] * xn1[2] + xn1[3] * xn1[3])); \
                if (next) { const f32x4 hv0 = xn0 * gn0, hv1 = xn1 * gn1; \
                    u32x4 w; w.x = pk2(hv0[0], hv0[1]); w.y = pk2(hv0[2], hv0[3]); w.z = pk2(hv1[0], hv1[1]); w.w = pk2(hv1[2], hv1[3]); *(u32x4*)(Hn + (unsigned)(rt + rl) * RP + c) = w; } } } while (0)
        RES_PROC(xA, 0); asm volatile("" ::: "memory");
        RES_LOAD(xA, 2); asm volatile("" ::: "memory");
        RES_PROC(xB, 1); asm volatile("" ::: "memory");
        RES_LOAD(xB, 3); asm volatile("" ::: "memory");
        RES_PROC(xA, 2); asm volatile("" ::: "memory");
        RES_PROC(xB, 3);
#undef RES_LOAD
#undef RES_PROC
        if (need_ss) {
#pragma unroll
            for (int ai = 0; ai < 2; ++ai)
#pragma unroll
                for (int m = 0; m < 4; ++m) { float t = ss[ai][m]; t += __shfl_xor(t, 16); t += __shfl_xor(t, 32);
                    if (fq == 0) sred[(wr * 64 + fr + ai * 128 + m * 16) * 4 + wc] = t; }
            asm volatile("s_waitcnt lgkmcnt(0)" ::: "memory"); __builtin_amdgcn_s_barrier(); asm volatile("" ::: "memory");
            if (tid < 256) { const f32x4 q = *(const LAS f32x4*)(sred + tid * 4); const float t = (q[0] + q[1]) + (q[2] + q[3]);
                if (!fin) PARTX[(unsigned)(rt + tid) * 4u + u.pn] = t;
                else { const __amdgpu_buffer_rsrc_t prs = __builtin_amdgcn_make_buffer_rsrc((void*)PARTX, 0, 0x7fffffff, 0x00020000);
                       __builtin_amdgcn_raw_buffer_store_b32(__builtin_bit_cast(unsigned, t), prs, ((unsigned)(rt + tid) * 4u + u.pn) * 4u, 0, 16  ); } }
        }
    }
};


template <class Epi> struct EpiTailT {
    static constexpr bool sched_tab = true;
    static __host__ __device__ __forceinline__ int brow(int R) { return Epi::brow(R); }
    __device__ __forceinline__ void prefetch(const pg8::Unit&, int, int, int) const {}
    float* slab; unsigned* flags;
    __device__ __forceinline__ void operator()(const f32x4 (&acc)[2][2][4][2], const pg8::Unit& u, int wr, int wc, int fr, int fq, int pbuf) const {
        const int tid = (wr * 4 + wc) * 64 + fq * 16 + fr; const unsigned ui = u.rng;
        const __amdgpu_buffer_rsrc_t rsrc = __builtin_amdgcn_make_buffer_rsrc((void*)slab, 0, 0x7fffffff, 0x00020000);
        const unsigned voff = ui * 131072u + (unsigned)tid * 16u;
#pragma unroll
        for (int ai = 0; ai < 2; ++ai)
#pragma unroll
            for (int bj = 0; bj < 2; ++bj)
#pragma unroll
                for (int m = 0; m < 4; ++m) { const f32x4 a = acc[ai][bj][m][0], b = acc[ai][bj][m][1];
                    u32x4 w; w.x = pkh2(a[0], a[1]); w.y = pkh2(a[2], a[3]); w.z = pkh2(b[0], b[1]); w.w = pkh2(b[2], b[3]);
                    __builtin_amdgcn_raw_buffer_store_b128(w, rsrc, voff, ((ai * 2 + bj) * 4 + m) * 8192, 16  ); }
        asm volatile("s_waitcnt vmcnt(0)" ::: "memory"); __builtin_amdgcn_s_barrier(); asm volatile("" ::: "memory");
        if (tid == 0) __hip_atomic_store(flags + ui * 64, 1u, __ATOMIC_RELAXED, __HIP_MEMORY_SCOPE_AGENT);
    }
};
template <class Epi> struct EpiHead {
    static constexpr bool sched_tab = true;
    static __host__ __device__ __forceinline__ int brow(int R) { return Epi::brow(R); }
    __device__ __forceinline__ void prefetch(const pg8::Unit& u, int wid, int lane, int pbuf) const { E.prefetch(u, wid, lane, pbuf); }
    Epi E; const float* slab; unsigned* flags; LAS unsigned char* lds3  ;
    __device__ __forceinline__ void operator()(f32x4 (&acc)[2][2][4][2], const pg8::Unit& u, int wr, int wc, int fr, int fq, int pbuf) const {
        const int tid = (wr * 4 + wc) * 64 + fq * 16 + fr; const unsigned ui = u.rng + 1;
        const bool head = u.role == 2;
        if (head) {
            if (tid == 0) { unsigned sp = 0;
                while (__hip_atomic_load(flags + ui * 64, __ATOMIC_RELAXED, __HIP_MEMORY_SCOPE_AGENT) == 0u) { __builtin_amdgcn_s_sleep(2); if (++sp > (1u << 22)) break; }
                __builtin_amdgcn_fence(__ATOMIC_ACQUIRE, "agent"); asm volatile("s_waitcnt vmcnt(0)" ::: "memory"); }
            asm volatile("s_waitcnt vmcnt(0) lgkmcnt(0)" ::: "memory"); __builtin_amdgcn_s_barrier(); asm volatile("" ::: "memory");
            const int w8 = wr * 4 + wc; const char* sp = (const char*)slab + (size_t)ui * 131072u + w8 * 1024;
#pragma unroll
            for (int g = 0; g < 16; ++g) dma1k(sp + g * 8192, lds3 + g * 8192 + w8 * 1024, (fq << 4) | fr);
            asm volatile("s_waitcnt vmcnt(0)" ::: "memory");
        }
        const unsigned lbase = head ? (unsigned)tid * 16u : (unsigned)XB_OFF; const int gmul = head ? 8192 : 0;
#pragma unroll
        for (int ai = 0; ai < 2; ++ai)
#pragma unroll
            for (int bj = 0; bj < 2; ++bj)
#pragma unroll
                for (int m = 0; m < 4; ++m) { const u32x4 t = *(const LAS u32x4*)(lds3 + lbase + ((ai * 2 + bj) * 4 + m) * gmul);
                    u32x2 lo, hi; lo.x = t.x; lo.y = t.y; hi.x = t.z; hi.y = t.w;
                    acc[ai][bj][m][0] = acc[ai][bj][m][0] + unpkh4(lo); acc[ai][bj][m][1] = acc[ai][bj][m][1] + unpkh4(hi);
                    asm volatile("" : "+v"(acc[ai][bj][m][0]), "+v"(acc[ai][bj][m][1]) :: "memory"); }
        asm volatile("s_waitcnt lgkmcnt(0)" ::: "memory");
        E(acc, u, wr, wc, fr, fq, pbuf);
    }
};

struct EpiQKV {
    static constexpr bool sched_tab = true;
    static __host__ __device__ __forceinline__ int brow(int R) { const int wc = R >> 5, n = (R >> 4) & 1, i = R & 15, fq = i >> 2, reg = i & 3; return 64 * wc + 32 * (fq >> 1) + 8 * (fq & 1) + 4 * n + reg; }
    bf16_t* Q; bf16_t* K; size_t kv_stride  ; const float* gainp  ; const float* PARTX; const float* bw  ; LAS float* prm; const LAS float* rope;
    __device__ __forceinline__ void prefetch(const pg8::Unit& u, int wid, int lane, int pbuf) const {
        const int rt = u.pm * 256; LAS unsigned char* pb = (LAS unsigned char*)prm + pbuf * PRM_STRIDE;
        if (wid < 4) dma1k(PARTX + (size_t)rt * 4 + wid * 256, pb + wid * 1024, lane);
        if (wid == 4) dma1k(bw + (size_t)(rt >= NLAT ? 4 : rt / L) * QKVW + u.pn * 256, pb + 4096, lane);
        if (wid == 5) dma1k(gainp, pb + 5120, lane);
    }
    __device__ __forceinline__ void operator()(f32x4 (&acc)[2][2][4][2], const pg8::Unit& u, int wr, int wc, int fr, int fq, int pbuf) const {
        const LAS float* prm = this->prm + pbuf * (PRM_STRIDE / 4);
        const int rt = u.pm * 256; const bool isctx = rt >= NLAT; const int type = u.pn < 4 ? 0 : u.pn - 3;
        const int dimbase = 32 * (fq >> 1) + 8 * (fq & 1);
        const int tid = (wr * 4 + wc) * 64 + fq * 16 + fr;
        { float rsx[2][4]; row_rs(prm, wr * 64 + fr, rsx);
#pragma unroll
          for (int bj = 0; bj < 2; ++bj)
#pragma unroll
              for (int n = 0; n < 2; ++n) { const f32x4 bwv = *(const LAS f32x4*)(prm + 1024 + wc * 64 + dimbase + 16 * bj + 4 * n);
#pragma unroll
                  for (int ai = 0; ai < 2; ++ai)
#pragma unroll
                      for (int m = 0; m < 4; ++m) acc[ai][bj][m][n] = acc[ai][bj][m][n] * rsx[ai][m] + bwv; } }
        const LAS float* gp = prm + (type == 0 ? 1280 : 1344) + dimbase;
        const float osc = type == 0 ? attn_body::C2 : 1.f;
#pragma unroll
        for (int ai = 0; ai < 2; ++ai)
#pragma unroll
            for (int m = 0; m < 4; ++m) {
                const int r = rt + wr * 64 + fr + ai * 128 + m * 16;
                f32x4 y[2][2];
#pragma unroll
                for (int bj = 0; bj < 2; ++bj)
#pragma unroll
                    for (int n = 0; n < 2; ++n) y[bj][n] = acc[ai][bj][m][n];
                if (type < 2) {
                    float ss = 0.f;
#pragma unroll
                    for (int bj = 0; bj < 2; ++bj)
#pragma unroll
                        for (int n = 0; n < 2; ++n) { const f32x4 a = y[bj][n]; ss += (a[0] * a[0] + a[1] * a[1]) + (a[2] * a[2] + a[3] * a[3]); }
                    ss += __shfl_xor(ss, 16); ss += __shfl_xor(ss, 32);
                    const float rs = rsqrtf(ss * (1.f / HD) + EPS) * osc;
#pragma unroll
                    for (int bj = 0; bj < 2; ++bj)
#pragma unroll
                        for (int n = 0; n < 2; ++n) y[bj][n] = y[bj][n] * rs * *(const LAS f32x4*)(gp + 16 * bj + 4 * n);
                    if (!isctx) {
                        const int t = r & (L - 1); const int pos = (fq >> 1) ? (t & 63) : (t >> 6);
#pragma unroll
                        for (int n = 0; n < 2; ++n) {
                            const f32x4 cs = *(const LAS f32x4*)(rope + pos * 16 + 8 * (fq & 1) + 4 * n), sn = *(const LAS f32x4*)(rope + 1024 + pos * 16 + 8 * (fq & 1) + 4 * n);
                            const f32x4 a = y[0][n], b = y[1][n];
                            y[0][n] = a * cs - b * sn; y[1][n] = b * cs + a * sn;
                        }
                    }
                }
                bf16_t* dst;
                if (type == 0) dst = Q + (unsigned)(r * RP + (4 * u.pn + wc) * 64);
                else { const int kvrow = isctx ? ((r - NLAT) >> 8) * (LC + L) + ((r - NLAT) & (LC - 1)) : (r >> 12) * (LC + L) + LC + (r & (L - 1));
                       dst = K + (size_t)(type - 1) * kv_stride + (unsigned)(kvrow * 256 + wc * 64); }
                u32x4 w0, w1;
                w0.x = pk2(y[0][0][0], y[0][0][1]); w0.y = pk2(y[0][0][2], y[0][0][3]); w0.z = pk2(y[0][1][0], y[0][1][1]); w0.w = pk2(y[0][1][2], y[0][1][3]);
                w1.x = pk2(y[1][0][0], y[1][0][1]); w1.y = pk2(y[1][0][2], y[1][0][3]); w1.z = pk2(y[1][1][0], y[1][1][1]); w1.w = pk2(y[1][1][2], y[1][1][3]);
#pragma unroll
                for (int e = 0; e < 4; ++e) { auto sw = __builtin_amdgcn_permlane32_swap(w0[e], w1[e], false, false); w0[e] = sw[0]; w1[e] = sw[1]; }
                *(u32x4*)(dst + 8 * fq) = w0; *(u32x4*)(dst + 32 + 8 * fq) = w1;
            }
    }
};

template <int CTRL> __device__ __forceinline__ float dppf(float oldv, float src) { return __builtin_bit_cast(float, __builtin_amdgcn_update_dpp(__builtin_bit_cast(int, oldv), __builtin_bit_cast(int, src), CTRL, 0xf, 0xf, false)); }
template <int CTRL> __device__ __forceinline__ float dppz(float src) { return __builtin_bit_cast(float, __builtin_amdgcn_update_dpp(0, __builtin_bit_cast(int, src), CTRL, 0xf, 0xf, true)); }
template <int CTRL> __device__ __forceinline__ f32x4 dpp4(f32x4 oldv, f32x4 src) { f32x4 r; r[0] = dppf<CTRL>(oldv[0], src[0]); r[1] = dppf<CTRL>(oldv[1], src[1]); r[2] = dppf<CTRL>(oldv[2], src[2]); r[3] = dppf<CTRL>(oldv[3], src[3]); return r; }
__device__ __forceinline__ float silu_fast(float g) { return g * __builtin_amdgcn_rcpf(1.f + __builtin_amdgcn_exp2f(-1.4426950408889634f * g)); }
__device__ __forceinline__ void conv_in(f32x4& r, const f32x4& x, const f32x4& w0, const f32x4& w2) {
    float r0 = r[0], r1 = r[1], r2 = r[2], r3 = r[3];
    asm volatile("s_nop 1\n\t"
                 "v_fmac_f32_dpp %0, %4, %8 row_shr:1 row_mask:0xf bank_mask:0xf bound_ctrl:0\n\t"
                 "v_fmac_f32_dpp %1, %5, %9 row_shr:1 row_mask:0xf bank_mask:0xf bound_ctrl:0\n\t"
                 "v_fmac_f32_dpp %2, %6, %10 row_shr:1 row_mask:0xf bank_mask:0xf bound_ctrl:0\n\t"
                 "v_fmac_f32_dpp %3, %7, %11 row_shr:1 row_mask:0xf bank_mask:0xf bound_ctrl:0\n\t"
                 "v_fmac_f32_dpp %0, %4, %12 row_shl:1 row_mask:0xf bank_mask:0xf bound_ctrl:0\n\t"
                 "v_fmac_f32_dpp %1, %5, %13 row_shl:1 row_mask:0xf bank_mask:0xf bound_ctrl:0\n\t"
                 "v_fmac_f32_dpp %2, %6, %14 row_shl:1 row_mask:0xf bank_mask:0xf bound_ctrl:0\n\t"
                 "v_fmac_f32_dpp %3, %7, %15 row_shl:1 row_mask:0xf bank_mask:0xf bound_ctrl:0"
                 : "+v"(r0), "+v"(r1), "+v"(r2), "+v"(r3)
                 : "v"(x[0]), "v"(x[1]), "v"(x[2]), "v"(x[3]), "v"(w0[0]), "v"(w0[1]), "v"(w0[2]), "v"(w0[3]), "v"(w2[0]), "v"(w2[1]), "v"(w2[2]), "v"(w2[3]));
    r = (f32x4){r0, r1, r2, r3};
}
template <bool PREV> __device__ __forceinline__ void conv_edge(f32x4& r, const f32x4& x, const f32x4& we) {
    float r0 = r[0], r1 = r[1], r2 = r[2], r3 = r[3];
    if (PREV) asm volatile("s_nop 1\n\t"
                 "v_fmac_f32_dpp %0, %4, %8 row_ror:1 row_mask:0xf bank_mask:0xf\n\t"
                 "v_fmac_f32_dpp %1, %5, %9 row_ror:1 row_mask:0xf bank_mask:0xf\n\t"
                 "v_fmac_f32_dpp %2, %6, %10 row_ror:1 row_mask:0xf bank_mask:0xf\n\t"
                 "v_fmac_f32_dpp %3, %7, %11 row_ror:1 row_mask:0xf bank_mask:0xf"
                 : "+v"(r0), "+v"(r1), "+v"(r2), "+v"(r3) : "v"(x[0]), "v"(x[1]), "v"(x[2]), "v"(x[3]), "v"(we[0]), "v"(we[1]), "v"(we[2]), "v"(we[3]));
    else asm volatile("s_nop 1\n\t"
                 "v_fmac_f32_dpp %0, %4, %8 row_ror:15 row_mask:0xf bank_mask:0xf\n\t"
                 "v_fmac_f32_dpp %1, %5, %9 row_ror:15 row_mask:0xf bank_mask:0xf\n\t"
                 "v_fmac_f32_dpp %2, %6, %10 row_ror:15 row_mask:0xf bank_mask:0xf\n\t"
                 "v_fmac_f32_dpp %3, %7, %11 row_ror:15 row_mask:0xf bank_mask:0xf"
                 : "+v"(r0), "+v"(r1), "+v"(r2), "+v"(r3) : "v"(x[0]), "v"(x[1]), "v"(x[2]), "v"(x[3]), "v"(we[0]), "v"(we[1]), "v"(we[2]), "v"(we[3]));
    r = (f32x4){r0, r1, r2, r3};
}
struct EpiUpConv {
    static constexpr bool sched_tab = true;
    static __host__ __device__ __forceinline__ int brow(int R) { const int rho = R & 31, n = rho >> 4, i = rho & 15; return (R & ~31) + 8 * (i >> 2) + 4 * n + (i & 3); }
    bf16_t* G; float* EDGE; const float* convp  ; LAS float* xb; const float* PARTX; const float* bwp  ; LAS float* prm;
    __device__ __forceinline__ void prefetch(const pg8::Unit& u, int wid, int lane, int pbuf) const {
        const int rt = u.pm * 256; LAS unsigned char* pb = (LAS unsigned char*)prm + pbuf * PRM_STRIDE;
        if (wid < 4) { dma1k(PARTX + (size_t)rt * 4 + wid * 256, pb + wid * 1024, lane); dma1k(convp + (size_t)u.pn * 1024 + wid * 256, pb + 5120 + wid * 1024, lane); }
        if (wid == 4) dma1k(bwp + ((size_t)(rt >= NLAT ? 4 : rt / L) * 22 + u.pn) * 256, pb + 4096, lane);
    }
    __device__ __forceinline__ void operator()(f32x4 (&acc)[2][2][4][2], const pg8::Unit& u, int wr, int wc, int fr, int fq, int pbuf) const {
        const LAS float* prm = this->prm + pbuf * (PRM_STRIDE / 4);
        constexpr int DPP_SHR1 = 0x111, DPP_SHL1 = 0x101, DPP_ROR1 = 0x121, DPP_ROL1 = 0x12F;
        const int colw = 32 * wc + 8 * fq, f0 = 128 * u.pn, rt = u.pm * 256;
        const int tid = (wr * 4 + wc) * 64 + fq * 16 + fr;
        { float rsx[2][4]; row_rs(prm, wr * 64 + fr, rsx);
#pragma unroll
          for (int bj = 0; bj < 2; ++bj)
#pragma unroll
              for (int n = 0; n < 2; ++n) { const f32x4 bwv = *(const LAS f32x4*)(prm + 1024 + bj * 128 + colw + 4 * n);
#pragma unroll
                  for (int ai = 0; ai < 2; ++ai)
#pragma unroll
                      for (int m = 0; m < 4; ++m) acc[ai][bj][m][n] = acc[ai][bj][m][n] * rsx[ai][m] + bwv; } }
#pragma unroll
        for (int ai = 0; ai < 2; ++ai) { const int q = 2 * ai + wr;
#pragma unroll
            for (int bj = 0; bj < 2; ++bj)
#pragma unroll
                for (int n = 0; n < 2; ++n) {
                    if (fr == 0) *(LAS f32x4*)(xb + (((q + 1) * 2 + 0) * 2 + bj) * 128 + colw + 4 * n) = acc[ai][bj][0][n];
                    if (fr == 15) *(LAS f32x4*)(xb + (((q + 1) * 2 + 1) * 2 + bj) * 128 + colw + 4 * n) = acc[ai][bj][3][n];
                } }
        if (wr == 0 && fr < 2) {
#pragma unroll
            for (int bj = 0; bj < 2; ++bj)
#pragma unroll
                for (int n = 0; n < 2; ++n) *(f32x4*)(EDGE + (unsigned)((u.pm * 4 + fr) * FF2 + bj * FF + f0 + colw + 4 * n)) = acc[0][bj][0][n]; }
        if (wr == 1 && fr >= 14) {
#pragma unroll
            for (int bj = 0; bj < 2; ++bj)
#pragma unroll
                for (int n = 0; n < 2; ++n) *(f32x4*)(EDGE + (unsigned)((u.pm * 4 + (fr - 12)) * FF2 + bj * FF + f0 + colw + 4 * n)) = acc[1][bj][3][n]; }
        asm volatile("s_waitcnt lgkmcnt(0)" ::: "memory"); __builtin_amdgcn_s_barrier(); asm volatile("" ::: "memory");
        const float m0 = fr == 0 ? 1.f : 0.f, m15 = fr == 15 ? 1.f : 0.f;
#pragma unroll
        for (int bj = 0; bj < 2; ++bj)
#pragma unroll
            for (int n = 0; n < 2; ++n) {
                const LAS float* pp = prm + 1024 + bj * 128 + colw + 4 * n;
                const f32x4 w0 = *(const LAS f32x4*)(pp + 256), w1 = *(const LAS f32x4*)(pp + 512), w2 = *(const LAS f32x4*)(pp + 768), bb = *(const LAS f32x4*)(pp + 1024);
                const f32x4 w0e = w0 * m0, w2e = w2 * m15;
#pragma unroll
                for (int ai = 0; ai < 2; ++ai) { const int q = 2 * ai + wr;
                    const f32x4 lo = *(const LAS f32x4*)(xb + ((q * 2 + 1) * 2 + bj) * 128 + colw + 4 * n);
                    const f32x4 hi = *(const LAS f32x4*)(xb + (((q + 2) * 2 + 0) * 2 + bj) * 128 + colw + 4 * n);
                    f32x4 saved = lo;
#pragma unroll
                    for (int m = 0; m < 4; ++m) {
                        const f32x4 cur = acc[ai][bj][m][n];
                        f32x4 r = w1 * cur + bb;
                        if (m == 0) r = r + lo * w0e; else conv_edge<true>(r, saved, w0e);
                        if (m == 3) r = r + hi * w2e; else conv_edge<false>(r, acc[ai][bj][m + 1][n], w2e);
                        conv_in(r, cur, w0, w2);
                        acc[ai][bj][m][n] = r;
                        saved = cur;
                    } }
            }
#pragma unroll
        for (int ai = 0; ai < 2; ++ai)
#pragma unroll
            for (int m = 0; m < 4; ++m) {
                const int r = rt + ai * 128 + wr * 64 + m * 16 + fr;
                float o[8];
#pragma unroll
                for (int n = 0; n < 2; ++n)
#pragma unroll
                    for (int e = 0; e < 4; ++e) { const float gp = acc[ai][1][m][n][e]; o[4 * n + e] = (gp * acc[ai][0][m][n][e]) * __builtin_amdgcn_rcpf(1.f + __builtin_amdgcn_exp2f(gp)); }
                u32x4 w; w.x = pk2(o[0], o[1]); w.y = pk2(o[2], o[3]); w.z = pk2(o[4], o[5]); w.w = pk2(o[6], o[7]);
                *(u32x4*)(G + (unsigned)(r * FF + f0 + colw)) = w;
            }
    }
};
__device__ __forceinline__ void ffn_fixup(const Frame& F, const float* cw, const float* cb, const float* EDGE, bf16_t* Gout) {
    PHASE_IDS
    const int total = 60 * 2 * (FF / 4);
    for (int i = bid * NT + tid; i < total; i += G * NT) {
        const int f = (i % (FF / 4)) * 4, which = (i / (FF / 4)) & 1, bd = i / (2 * (FF / 4));
        const int pmA = (bd / 15) * 16 + bd % 15, pmB = pmA + 1;
        const float* um = which == 0 ? EDGE + ((size_t)pmA * 4 + 2) * FF2 : EDGE + ((size_t)pmA * 4 + 3) * FF2;
        const float* uc = which == 0 ? EDGE + ((size_t)pmA * 4 + 3) * FF2 : EDGE + ((size_t)pmB * 4 + 0) * FF2;
        const float* up = which == 0 ? EDGE + ((size_t)pmB * 4 + 0) * FF2 : EDGE + ((size_t)pmB * 4 + 1) * FF2;
        const int r = pmB * 256 - 1 + which;
        f32x4 a[2];
#pragma unroll
        for (int part = 0; part < 2; ++part) { const int col = part * FF + f;
            a[part] = *(const f32x4*)(cw + col) * *(const f32x4*)(um + col) + *(const f32x4*)(cw + FF2 + col) * *(const f32x4*)(uc + col) + *(const f32x4*)(cw + 2 * FF2 + col) * *(const f32x4*)(up + col) + *(const f32x4*)(cb + col); }
        u32x2 w; w.x = pk2(silu_fast(a[1][0]) * a[0][0], silu_fast(a[1][1]) * a[0][1]); w.y = pk2(silu_fast(a[1][2]) * a[0][2], silu_fast(a[1][3]) * a[0][3]);
        *(u32x2*)(Gout + (size_t)r * FF + f) = w;
    }
}


__device__ __forceinline__ float gelu_fast(float x) { const float u = x * __builtin_fmaf(x * x, -2.885390081777927f * 0.7978845608028654f * 0.044715f, -2.885390081777927f * 0.7978845608028654f); return x * __builtin_amdgcn_rcpf(1.f + __builtin_amdgcn_exp2f(u)); }
struct EpiGelu {
    static constexpr bool sched_tab = true;
    static __host__ __device__ __forceinline__ int brow(int R) { const int rho = R & 31, n = rho >> 4, i = rho & 15; return (R & ~31) + 8 * (i >> 2) + 4 * n + (i & 3); }
    bf16_t* U; bf16_t* V; float* PART; const float* PARTX; const float* bw  ; LAS float* prm;
    __device__ __forceinline__ void prefetch(const pg8::Unit& u, int wid, int lane, int pbuf) const {
        const int rt = u.pm * 256; LAS unsigned char* pb = (LAS unsigned char*)prm + pbuf * PRM_STRIDE;
        if (wid < 4) dma1k(PARTX + (size_t)rt * 4 + wid * 256, pb + wid * 1024, lane);
        if (wid == 4) dma1k(bw + (size_t)(rt >= NLAT ? 4 : rt / L) * 2048 + u.pn * 256, pb + 4096, lane);
    }
    __device__ __forceinline__ void operator()(f32x4 (&acc)[2][2][4][2], const pg8::Unit& u, int wr, int wc, int fr, int fq, int pbuf) const {
        const LAS float* prm = this->prm + pbuf * (PRM_STRIDE / 4);
        const bool isv = u.pn >= 4; bf16_t* dstb = isv ? V : U; const int colt = (u.pn & 3) * 256 + wc * 32 + 8 * fq;
        const int rt = u.pm * 256, tid = (wr * 4 + wc) * 64 + fq * 16 + fr;
        { float rsx[2][4]; row_rs(prm, wr * 64 + fr, rsx);
#pragma unroll
          for (int bj = 0; bj < 2; ++bj)
#pragma unroll
              for (int n = 0; n < 2; ++n) { const f32x4 bwv = *(const LAS f32x4*)(prm + 1024 + 128 * bj + wc * 32 + 8 * fq + 4 * n);
#pragma unroll
                  for (int ai = 0; ai < 2; ++ai)
#pragma unroll
                      for (int m = 0; m < 4; ++m) acc[ai][bj][m][n] = acc[ai][bj][m][n] * rsx[ai][m] + bwv; } }
#pragma unroll
        for (int ai = 0; ai < 2; ++ai)
#pragma unroll
            for (int m = 0; m < 4; ++m) { const int r = rt + wr * 64 + fr + ai * 128 + m * 16; f32x4 ssv = {0.f, 0.f, 0.f, 0.f};
#pragma unroll
                for (int bj = 0; bj < 2; ++bj) { float z[8];
#pragma unroll
                    for (int n = 0; n < 2; ++n) {
                        const f32x4 x = acc[ai][bj][m][n]; const f32x4 uu = x * ((x * x) * (-2.885390081777927f * 0.7978845608028654f * 0.044715f) + (-2.885390081777927f * 0.7978845608028654f));
                        f32x4 den; den[0] = __builtin_amdgcn_exp2f(uu[0]); den[1] = __builtin_amdgcn_exp2f(uu[1]); den[2] = __builtin_amdgcn_exp2f(uu[2]); den[3] = __builtin_amdgcn_exp2f(uu[3]);
                        den = den + 1.f;
                        f32x4 rc; rc[0] = __builtin_amdgcn_rcpf(den[0]); rc[1] = __builtin_amdgcn_rcpf(den[1]); rc[2] = __builtin_amdgcn_rcpf(den[2]); rc[3] = __builtin_amdgcn_rcpf(den[3]);
                        const f32x4 zz = x * rc; ssv = ssv + zz * zz;
                        z[4 * n + 0] = zz[0]; z[4 * n + 1] = zz[1]; z[4 * n + 2] = zz[2]; z[4 * n + 3] = zz[3]; }
                    u32x4 w; w.x = pk2(z[0], z[1]); w.y = pk2(z[2], z[3]); w.z = pk2(z[4], z[5]); w.w = pk2(z[6], z[7]);
                    *(u32x4*)(dstb + (unsigned)(r * RP + colt + bj * 128)) = w; }
                if (isv) { float ss = (ssv[0] + ssv[1]) + (ssv[2] + ssv[3]); ss += __shfl_xor(ss, 16); ss += __shfl_xor(ss, 32); if (fq == 0) PART[(unsigned)(r * 16 + (u.pn - 4) * 4 + wc)] = ss; }
            }
    }
};
__device__ __forceinline__ void sgu_spatial(const Frame& F, const float* w_s, const float* b_s, const float* vg, const bf16_t* U, const bf16_t* V, const float* PART, bf16_t* Og, int nrows) {
    PHASE_IDS
    typedef short v4i16_t __attribute__((ext_vector_type(4)));
    LAS unsigned char* Vs = F.lds3; LAS float* rsv = (LAS float*)(F.lds3 + 128 * 288);
    const int fr = lane & 15, fq = lane >> 4;
    const int nitems = (nrows / 128) * 8;
    const int m = 16 * wave + fr;
    u32x4 vt[4]; f32x4 pq[4]; f32x4 wa[4][2]; u32x4 uwn[4]; f32x4 gvn[8]; float bsn = 0.f;
#define SGU_LOAD(it_) do { const int ch_ = (it_) >> 3, g_ = (it_) & 7, row0_ = ch_ * 128; \
        _Pragma("unroll") for (int i = 0; i < 4; ++i) { const int e = tid + i * 512, n = e >> 4, c16 = e & 15; vt[i] = *(const u32x4*)(V + (size_t)(row0_ + n) * RP + g_ * 128 + c16 * 8); } \
        if (tid < 128) { _Pragma("unroll") for (int i = 0; i < 4; ++i) pq[i] = *(const f32x4*)(PART + (size_t)(row0_ + tid) * 16 + i * 4); } \
        _Pragma("unroll") for (int ks = 0; ks < 4; ++ks) { const float* wp = w_s + ((size_t)g_ * 128 + m) * 128 + 32 * ks + 8 * fq; wa[ks][0] = *(const f32x4*)wp; wa[ks][1] = *(const f32x4*)(wp + 4); } \
        _Pragma("unroll") for (int cb = 0; cb < 4; ++cb) { const int col = g_ * 128 + 32 * cb + 8 * fq; uwn[cb] = *(const u32x4*)(U + (size_t)(row0_ + m) * RP + col); gvn[2 * cb] = *(const f32x4*)(vg + col); gvn[2 * cb + 1] = *(const f32x4*)(vg + col + 4); } \
        bsn = b_s[g_ * 128 + m]; } while (0)
    if (bid < nitems) SGU_LOAD(bid);
    for (int item = bid; item < nitems; item += G) {
        const int ch = item >> 3, g = item & 7, row0 = ch * 128;
        __syncthreads();
#pragma unroll
        for (int i = 0; i < 4; ++i) { const int e = tid + i * 512, n = e >> 4, c16 = e & 15; *(LAS u32x4*)(Vs + n * 288 + c16 * 16) = vt[i]; }
        if (tid < 128) { float sq = 0.f;
#pragma unroll
            for (int i = 0; i < 4; ++i) sq += (pq[i][0] + pq[i][1]) + (pq[i][2] + pq[i][3]);
            rsv[tid] = rsqrtf(sq * (1.f / D) + EPS); }
        __syncthreads();
        bf16x8 af[4];
#pragma unroll
        for (int ks = 0; ks < 4; ++ks) { const int k0 = 32 * ks + 8 * fq; const f32x4 a0 = wa[ks][0], a1 = wa[ks][1]; const f32x4 r0 = *(const LAS f32x4*)(rsv + k0), r1 = *(const LAS f32x4*)(rsv + k0 + 4);
            u32x4 w; w.x = pk2(a0[0] * r0[0], a0[1] * r0[1]); w.y = pk2(a0[2] * r0[2], a0[3] * r0[3]); w.z = pk2(a1[0] * r1[0], a1[1] * r1[1]); w.w = pk2(a1[2] * r1[2], a1[3] * r1[3]);
            af[ks] = __builtin_bit_cast(bf16x8, w); }
        u32x4 uw[4]; f32x4 gvv[8]; const float bsv = bsn;
#pragma unroll
        for (int cb = 0; cb < 4; ++cb) { uw[cb] = uwn[cb]; gvv[2 * cb] = gvn[2 * cb]; gvv[2 * cb + 1] = gvn[2 * cb + 1]; }
        asm volatile("" ::: "memory");
        if (item + G < nitems) SGU_LOAD(item + G);
        const int q = fr >> 2, pq2 = fr & 3;
#pragma unroll
        for (int cb = 0; cb < 4; ++cb) {
            f32x4 acc0 = {0.f, 0.f, 0.f, 0.f}, acc1 = {0.f, 0.f, 0.f, 0.f};
#pragma unroll
            for (int ks = 0; ks < 4; ++ks) {
                LAS unsigned char* ap = Vs + (32 * ks + 8 * fq + q) * 288 + (32 * cb + 8 * pq2) * 2;
                const v4i16_t lo = __builtin_amdgcn_ds_read_tr16_b64_v4i16((LAS v4i16_t*)ap), hi = __builtin_amdgcn_ds_read_tr16_b64_v4i16((LAS v4i16_t*)(ap + 4 * 288));
                const v4i16_t lo1 = __builtin_amdgcn_ds_read_tr16_b64_v4i16((LAS v4i16_t*)(ap + 8)), hi1 = __builtin_amdgcn_ds_read_tr16_b64_v4i16((LAS v4i16_t*)(ap + 8 + 4 * 288));
                const bf16x8 vf = {lo[0], lo[1], lo[2], lo[3], hi[0], hi[1], hi[2], hi[3]}, vf1 = {lo1[0], lo1[1], lo1[2], lo1[3], hi1[0], hi1[1], hi1[2], hi1[3]};
                acc0 = __builtin_amdgcn_mfma_f32_16x16x32_bf16(vf, af[ks], acc0, 0, 0, 0);
                acc1 = __builtin_amdgcn_mfma_f32_16x16x32_bf16(vf1, af[ks], acc1, 0, 0, 0);
            }
            const int col = g * 128 + 32 * cb + 8 * fq; const size_t off = (size_t)(row0 + m) * RP + col;
            const f32x4 gv0 = gvv[2 * cb], gv1 = gvv[2 * cb + 1]; const u32x4 uwv = uw[cb];
#define BFLO(x) __builtin_bit_cast(float, (x) << 16)
#define BFHI(x) __builtin_bit_cast(float, (x) & 0xffff0000u)
            u32x4 w;
            w.x = pk2(BFLO(uwv.x) * (acc0[0] * gv0[0] + bsv), BFHI(uwv.x) * (acc0[1] * gv0[1] + bsv)); w.y = pk2(BFLO(uwv.y) * (acc0[2] * gv0[2] + bsv), BFHI(uwv.y) * (acc0[3] * gv0[3] + bsv));
            w.z = pk2(BFLO(uwv.z) * (acc1[0] * gv1[0] + bsv), BFHI(uwv.z) * (acc1[1] * gv1[1] + bsv)); w.w = pk2(BFLO(uwv.w) * (acc1[2] * gv1[2] + bsv), BFHI(uwv.w) * (acc1[3] * gv1[3] + bsv));
#undef BFLO
#undef BFHI
            *(u32x4*)(Og + off) = w;
        }
    }
#undef SGU_LOAD
    __syncthreads();
}

__device__ __forceinline__ void p0_transpose_item(const float* W, int K, int N, bf16_t* WT, int ldw, int row_off, float* scr, int item, int lane) {
    const int nblk = N / 32, kb = item / nblk, nb = item % nblk, k0 = 64 * kb, n0 = 32 * nb;
    float wv[32];
#pragma unroll
    for (int i = 0; i < 32; ++i) wv[i] = __builtin_nontemporal_load(&W[(size_t)(k0 + 2 * i + (lane >> 5)) * N + n0 + (lane & 31)]);
#pragma unroll
    for (int i = 0; i < 32; ++i) scr[(2 * i + (lane >> 5)) * 33 + (lane & 31)] = wv[i];
    asm volatile("s_waitcnt lgkmcnt(0)" ::: "memory");
    const int c = lane & 7;
#pragma unroll
    for (int j = 0; j < 4; ++j) { const int n = (lane >> 3) + 8 * j; const float* s = scr + (8 * c) * 33 + n;
        u32x4 o; o.x = pk2(s[0 * 33], s[1 * 33]); o.y = pk2(s[2 * 33], s[3 * 33]); o.z = pk2(s[4 * 33], s[5 * 33]); o.w = pk2(s[6 * 33], s[7 * 33]);
        *(u32x4*)(WT + (size_t)(row_off + n0 + n) * ldw + k0 + 8 * c) = o; }
    asm volatile("s_waitcnt lgkmcnt(0)" ::: "memory");
}

template <int PART> __device__ __forceinline__ void p0_weights(const Frame& F, const Params& p, int rank, int nranks) {
    PHASE_IDS
    float* scr = F.lds + wave * (64 * 33);
    const int gw = rank * NWAVES + wave, NGW = nranks * NWAVES;
    constexpr int I_QKV = 16 * 48, I_WO_ = 16 * 32, I_POOL = 4 * 8, I_WIN = 16 * 64, I_WOUT = 16 * 32, I_UP = 16 * 176, I_DN = 44 * 32;
#define P0_UP(l, r_) p0_transpose_item(IN(I_WUP) + (size_t)(l) * D * FF2, D, FF2, WSP(bf16_t, WS_WUP) + (size_t)(l) * FF2 * RP, RP, 0, scr, (r_), lane)
#define P0_QKV(j, r_) p0_transpose_item(IN(I_WQKV) + (size_t)(j) * D * QKVW, D, QKVW, WSP(bf16_t, WS_WQKV) + (size_t)(j) * QKVW * RP, RP, 0, scr, (r_), lane)
    if (PART == 0) {
        for (int it = gw; it < I_QKV + I_WO_ + 2 * I_UP; it += NGW) {
            int r = it;
            if (r < I_QKV) { P0_QKV(0, r); continue; } r -= I_QKV;
            if (r < I_WO_) { p0_transpose_item(IN(I_WO), D, D, WSP(bf16_t, WS_WO), RP, 0, scr, r, lane); continue; } r -= I_WO_;
            { const int l = r / I_UP; P0_UP(l, r % I_UP); }
        }
    } else if (PART == 1) {
        for (int it = gw; it < I_WO_ + 4 * I_POOL + I_WOUT + 4 * I_DN; it += NGW) {
            int r = it;
            if (r < I_WO_) { p0_transpose_item(IN(I_WO) + (size_t)D * D, D, D, WSP(bf16_t, WS_WO) + (size_t)D * RP, RP, 0, scr, r, lane); continue; } r -= I_WO_;
            if (r < 4 * I_POOL) { const int g = r / I_POOL; p0_transpose_item(IN(I_POOLW) + (size_t)g * 65536, 256, 256, WSP(bf16_t, WS_WPOOL), RPP, g * 256, scr, r % I_POOL, lane); continue; } r -= 4 * I_POOL;
            if (r < I_WOUT) { p0_transpose_item(IN(I_SWOUT), D, D, WSP(bf16_t, WS_WOUT), RP, 0, scr, r, lane); continue; } r -= I_WOUT;
            { const int l = r / I_DN; p0_transpose_item(IN(I_WDN) + (size_t)l * FF * D, FF, D, WSP(bf16_t, WS_WDN) + (size_t)l * D * FF, FF, 0, scr, r % I_DN, lane); }
        }
    } else if (PART == 2) {
        for (int it = gw; it < I_WIN; it += NGW) p0_transpose_item(IN(I_SWIN), D, 2048, WSP(bf16_t, WS_WIN), RP, 0, scr, it, lane);
    } else if (PART == 3) {
        for (int it = gw; it < I_UP; it += NGW) P0_UP(2, it);
    } else {
        for (int it = gw; it < I_QKV + I_UP; it += NGW) { if (it < I_QKV) P0_QKV(1, it); else P0_UP(3, it - I_QKV); }
    }
#undef P0_UP
#undef P0_QKV
}

__device__ __forceinline__ void p0_mod(const Frame& F, const Params& p, int layer, int rank, int nranks) {
    PHASE_IDS
    float* sv = F.lds;
    float* red = F.lds + 5 * 1024;
    const float* cvec = IN(I_C); const float* cctx = IN(I_CCTX); const float* ada_w = IN(I_ADAW); const float* ada_b = IN(I_ADAB); float* MOD = WSP(float, WS_MOD);
    for (int i = tid; i < 5 * 1024; i += NT) { const int v = i >> 10, k = i & 1023; const float xv = v < 4 ? cvec[v * D + k] : cctx[k]; sv[i] = silu_f(xv); }
    __syncthreads();
    const int cg4 = tid & 7, kr = tid >> 3;
    for (int item = rank; item < 192; item += nranks) {
        const int n0 = item * 32;
        const float* W = ada_w + (size_t)layer * D * 6144 + n0 + cg4 * 4;
        float acc[5][4];
#pragma unroll
        for (int v = 0; v < 5; ++v)
#pragma unroll
            for (int j = 0; j < 4; ++j) acc[v][j] = 0.f;
#pragma unroll 8
        for (int k = kr; k < D; k += 64) {
            const f32x4 w_ = __builtin_nontemporal_load((const f32x4*)(W + (size_t)k * 6144)); const float4 w = {w_[0], w_[1], w_[2], w_[3]};
#pragma unroll
            for (int v = 0; v < 5; ++v) { const float s = sv[v * 1024 + k]; acc[v][0] += s * w.x; acc[v][1] += s * w.y; acc[v][2] += s * w.z; acc[v][3] += s * w.w; }
        }
        __syncthreads();
#pragma unroll
        for (int v = 0; v < 5; ++v)
#pragma unroll
            for (int j = 0; j < 4; ++j) red[(kr * 5 + v) * 32 + cg4 * 4 + j] = acc[v][j];
        __syncthreads();
        if (tid < 160) {
            const int v = tid >> 5, col = tid & 31;
            float s = 0.f;
            for (int q = 0; q < 64; ++q) s += red[(q * 5 + v) * 32 + col];
            MOD[(size_t)(layer * 5 + v) * 6144 + n0 + col] = s + ada_b[layer * 6144 + n0 + col];
        }
        __syncthreads();
    }
}

__device__ __forceinline__ void final_norm(const Frame& F, const float* fnw) {
    PHASE_IDS
    const bf16_t* XB = WSP(bf16_t, WS_XB);
    for (int r2 = bid * 8 + wave; r2 < NLAT / 2; r2 += G * 8) {
        u32x2 w[2][4];
#pragma unroll
        for (int q = 0; q < 2; ++q)
#pragma unroll
            for (int j = 0; j < 4; ++j) w[q][j] = *(const u32x2*)(XB + (size_t)(2 * r2 + q) * RP + j * 256 + lane * 4);
#pragma unroll
        for (int q = 0; q < 2; ++q) { float* orow = F.X + (size_t)(2 * r2 + q) * D; f32x4 xv[4]; float ss = 0.f;
#pragma unroll
            for (int j = 0; j < 4; ++j) { xv[j] = unpkh4(w[q][j]); ss += (xv[j][0] * xv[j][0] + xv[j][1] * xv[j][1]) + (xv[j][2] * xv[j][2] + xv[j][3] * xv[j][3]); }
            const float rs = rsqrtf(wave_sum(ss) * (1.f / D) + EPS);
#pragma unroll
            for (int j = 0; j < 4; ++j) { const int c = j * 256 + lane * 4; __builtin_nontemporal_store(xv[j] * rs * *(const f32x4*)(fnw + c), (f32x4*)(orow + c)); } }
    }
}


__device__ __forceinline__ void p0_rope(const Frame& F) {
    PHASE_IDS
    if (bid < 16 && tid < 64) { float* rc = WSP(float, WS_ROPE); float* rsn = rc + 1024;
        { const int i = bid * 64 + tid; const int pos = i >> 4, fi = i & 15; const float ang = (float)pos * powf(10000.f, -(float)fi / 16.f); rc[i] = cosf(ang); rsn[i] = sinf(ang); } }
}
__device__ __forceinline__ void attn_phase(const Frame& F, const float* qg, const float* kg, bool with_ctx) {
    PHASE_IDS
    float gqm = 0.f, gkm = 0.f;
    for (int i = 0; i < HD; ++i) { gqm = fmaxf(gqm, fabsf(qg[i])); gkm = fmaxf(gkm, fabsf(kg[i])); }
    const float m2 = 8.f * gqm * gkm * 1.4426950408889634f;
    bf16_t* Q = WSP(bf16_t, WS_Q); const bf16_t* K = WSP(bf16_t, WS_K); const bf16_t* V = WSP(bf16_t, WS_V);
    const int vcu = (G % 8 == 0) ? (bid % 8) * (G / 8) + bid / 8 : bid;
    for (int s = vcu; s < 256; s += G) {
        const int pair = s >> 4, b = pair >> 2, kvh = pair & 3, qb = s & 15;
        attn_body::attn_unit(b * L + qb * 256, kvh * 4, 4, b * (LC + L), kvh, (LC + L) / 64, m2, Q, K, V, (char*)F.lds);
    }
    if (with_ctx) for (int s = vcu; s < 64; s += G) { const int b = s >> 4, h = s & 15; attn_body::attn_unit(NLAT + b * LC, h, 1, b * (LC + L), h >> 2, LC / 64, m2, Q, K, V, (char*)F.lds); }
}


template <int SET> __device__ __forceinline__ void bias_gemv(const Frame& F, int rank, int nranks) {
    PHASE_IDS
    const int gw = rank * NWAVES + wave, NGW = nranks * NWAVES;
    const float* MOD = WSP(float, WS_MOD); float* BW = WSP(float, WS_BIASW);
    LAS bf16_t* shb = (LAS bf16_t*)F.lds3;
    constexpr int NSEG = SET == 1 ? 1 : 2; constexpr int SEGA = SET == 0 ? 0 : SET == 1 ? 4 : SET == 2 ? 2 : 1, SEGB = SET == 0 ? 3 : SET == 2 ? 5 : 6;
    for (int i = tid; i < NSEG * 5 * 256; i += NT) { const int si = i / 1280, r = i % 1280, v = r >> 8, k4 = (r & 255) * 4;
        const int seg = si == 0 ? SEGA : SEGB;
        const int layer = seg < 2 ? 3 * seg : seg == 2 ? 2 : seg - 3, part = seg < 3 ? 0 : 3;
        const f32x4 x = *(const f32x4*)(MOD + ((size_t)(layer * 5 + v) * 6 + part) * D + k4);
        u32x2 w; w.x = pk2(x[0], x[1]); w.y = pk2(x[2], x[3]); *(LAS u32x2*)(shb + (seg * 5 + v) * 1024 + k4) = w; }
    __syncthreads();
    const int fr = lane & 15, fq = lane >> 4;
    constexpr int NG_QKV = QKVW / 16, NG_WIN = 2048 / 16, NG_UP = FF2 / 16, NGA = SEGA < 2 ? NG_QKV : SEGA == 2 ? NG_WIN : NG_UP, NG_ALL = NGA + (NSEG == 2 ? NG_UP : 0);
    for (int gi = gw; gi < NG_ALL; gi += NGW) {
        int seg, grp; const bf16_t* Wt; int N;
        if (gi < NGA) { seg = SEGA; grp = gi; } else { seg = SEGB; grp = gi - NGA; }
        if (seg < 2) { Wt = WSP(bf16_t, WS_WQKV) + (size_t)seg * QKVW * RP; N = QKVW; } else if (seg == 2) { Wt = WSP(bf16_t, WS_WIN); N = 2048; } else { Wt = WSP(bf16_t, WS_WUP) + (size_t)(seg - 3) * FF2 * RP; N = FF2; }
        const bf16_t* wrow = Wt + (size_t)(grp * 16 + fr) * RP + 8 * fq;
        const LAS bf16_t* srow = shb + (seg * 5 + (fr < 5 ? fr : 0)) * 1024 + 8 * fq;
        f32x4 acc = {0.f, 0.f, 0.f, 0.f};
#pragma unroll
        for (int kb = 0; kb < 4; ++kb) { bf16x8 bfr[8];
#pragma unroll
            for (int j = 0; j < 8; ++j) bfr[j] = *(const bf16x8*)(wrow + (kb * 8 + j) * 32);
#pragma unroll
            for (int j = 0; j < 8; ++j) { bf16x8 afr = *(const LAS bf16x8*)(srow + (kb * 8 + j) * 32); if (fr >= 5) afr = (bf16x8){0, 0, 0, 0, 0, 0, 0, 0};
                acc = __builtin_amdgcn_mfma_f32_16x16x32_bf16(afr, bfr[j], acc, 0, 0, 0); } }
        const int n = grp * 16 + fr; float* out = seg < 2 ? BW + BW_QKV + (size_t)seg * 5 * QKVW : seg == 2 ? BW + BW_WIN : BW + BW_UP + (size_t)(seg - 3) * 5 * FF2;
        const int half = n >= FF, f = n - half * FF;
#pragma unroll
        for (int reg = 0; reg < 4; ++reg) { const int v = 4 * fq + reg;
            if (v < 5) { if (seg < 3) out[(size_t)v * N + n] = acc[reg]; else out[((size_t)v * 22 + (f >> 7)) * 256 + half * 128 + (f & 127)] = acc[reg]; } }
    }
    __syncthreads();
}

__device__ __forceinline__ void p1_prep(const Frame& F, const Params& p) {
    PHASE_IDS
    const int gw = bid * NWAVES + wave, NGW = G * NWAVES;
    const float* MOD = WSP(float, WS_MOD); float* BW = WSP(float, WS_BIASW);
    bias_gemv<0>(F, bid, G);
    {
        const float* cw = IN(I_CONVW); const float* cb = IN(I_CONVB); float* CP = BW + BW_CONVP;
        for (int i = bid * NT + tid; i < 4 * 22 * 1024; i += G * NT) { const int l = i / (22 * 1024), r = i % (22 * 1024), pn = r >> 10, k = (r >> 8) & 3, half = (r >> 7) & 1, e = r & 127;
            const int col = half * FF + pn * 128 + e; CP[i] = (k < 3 ? cw[(size_t)(l * 3 + k) * FF2 + col] : cb[(size_t)l * FF2 + col]) * (half ? -1.4426950408889634f : -0.6931471805599453f); }
        if (bid == 0) { const float* qg = IN(I_QG); const float* kg = IN(I_KG); float* GP = BW + BW_GAINP;
            for (int i = tid; i < 512; i += NT) { const int j = i >> 8, e = i & 255; GP[i] = e < 64 ? qg[j * 64 + e] : e < 128 ? kg[j * 64 + e - 64] : 0.f; } }
    }
    {
        const float* xl = IN(I_X); const float* xc = IN(I_CTX); const float* nw = IN(I_NORMW); bf16_t* H = WSP(bf16_t, WS_H); float* PARTX = WSP(float, WS_PARTX);
        for (int r2 = gw; r2 < NTOK / 2; r2 += NGW) {
            f32x4 xv[2][4]; float ss[2] = {0.f, 0.f};
#pragma unroll
            for (int q = 0; q < 2; ++q) { const int r = 2 * r2 + q; const float* xr = r < NLAT ? xl + (size_t)r * D : xc + (size_t)(r - NLAT) * D;
#pragma unroll
                for (int jj = 0; jj < 4; ++jj) xv[q][jj] = __builtin_nontemporal_load((const f32x4*)(xr + jj * 256 + lane * 4)); }
#pragma unroll
            for (int q = 0; q < 2; ++q) { const int r = 2 * r2 + q; const float* sc = MOD + ((size_t)vidx(r) * 6 + 1) * D;
#pragma unroll
                for (int jj = 0; jj < 4; ++jj) { const int c = jj * 256 + lane * 4; const f32x4 x = xv[q][jj];
                    ss[q] += (x[0] * x[0] + x[1] * x[1]) + (x[2] * x[2] + x[3] * x[3]);
                    const f32x4 hv = x * (*(const f32x4*)(nw + c)) * (*(const f32x4*)(sc + c) + 1.f);
                    u32x2 w; w.x = pk2(hv[0], hv[1]); w.y = pk2(hv[2], hv[3]); *(u32x2*)(H + (size_t)r * RP + c) = w;
                    u32x2 xw; xw.x = pkh2(x[0], x[1]); xw.y = pkh2(x[2], x[3]); *(u32x2*)(WSP(bf16_t, WS_XB) + (size_t)r * RP + c) = xw; }
                const float t = wave_sum(ss[q]);
                if (lane < 4) PARTX[(size_t)r * 4 + lane] = lane == 0 ? t : 0.f; }
        }
    }
}

template <int WIN> __device__ __forceinline__ void pool_rows(const bf16_t* Hs, const LAS float* rsl, bf16_t* P, int r0, int half, int c, int sbase, int Ls) {
    f32x4 pre[32];
    u32x2 raw[31];
#pragma unroll
    for (int i = 0; i < 31; ++i) { int row = r0 + 16 * half - 8 + i; row = row < 0 ? 0 : (row > NTOK - 1 ? NTOK - 1 : row); raw[i] = *(const u32x2*)(Hs + (size_t)row * RP + c); }
    pre[0] = (f32x4){0.f, 0.f, 0.f, 0.f};
#pragma unroll
    for (int i = 0; i < 31; ++i) { const float rsv = rsl[16 * half + i];
        const f32x4 v = {__builtin_bit_cast(float, raw[i].x << 16), __builtin_bit_cast(float, raw[i].x & 0xffff0000u), __builtin_bit_cast(float, raw[i].y << 16), __builtin_bit_cast(float, raw[i].y & 0xffff0000u)};
        pre[i + 1] = pre[i] + v * rsv; }
#pragma unroll
    for (int q = 0; q < 16; ++q) {
        const int i = q + 8;
        const int t = r0 + 16 * half + q - sbase;
        int lo = t - WIN / 2; if (lo < 0) lo = 0;
        int hi = t + WIN - WIN / 2 - 1; if (hi > Ls - 1) hi = Ls - 1;
        const float ic = 1.f / (float)(hi - lo + 1);
        const f32x4 wsum = pre[i + WIN - WIN / 2] - pre[i - WIN / 2], self = pre[i + 1] - pre[i];
        const f32x4 o = wsum * ic - self;
        u32x2 w; w.x = pk2(o[0], o[1]); w.y = pk2(o[2], o[3]);
        *(u32x2*)(P + (size_t)(r0 + 16 * half + q) * RP + c) = w;
    }
}
__device__ __forceinline__ void pool_prep2(const Frame& F, const bf16_t* Hs, const float* PARTX, bf16_t* P) {
    PHASE_IDS
    LAS float* rsl = (LAS float*)F.lds3;
    const int half = tid >> 8, c = (tid & 255) * 4, g = (wave & 3);
    for (int tile = bid; tile < NTOK / 32; tile += G) {
        const int r0 = tile * 32; int sbase, Ls;
        if (r0 < NLAT) { sbase = r0 & ~(L - 1); Ls = L; } else { sbase = NLAT + ((r0 - NLAT) & ~(LC - 1)); Ls = LC; }
        __syncthreads();
        if (tid < 48) { const int rr = r0 - 8 + tid; float rsv = 0.f;
            if (rr >= sbase && rr < sbase + Ls) { const f32x4 q = *(const f32x4*)(PARTX + (size_t)rr * 4);
                rsv = rsqrtf(((q[0] + q[1]) + (q[2] + q[3])) * (1.f / D) + EPS); }
            rsl[tid] = rsv; }
        __syncthreads();
        if (g == 0) pool_rows<2>(Hs, rsl, P, r0, half, c, sbase, Ls);
        else if (g == 1) pool_rows<4>(Hs, rsl, P, r0, half, c, sbase, Ls);
        else if (g == 2) pool_rows<8>(Hs, rsl, P, r0, half, c, sbase, Ls);
        else pool_rows<16>(Hs, rsl, P, r0, half, c, sbase, Ls);
    }
    __syncthreads();
}

__device__ __forceinline__ void pool_prep_units(const Frame& F, const pg8::StaticOrder& S, const bf16_t* Hs, const float* PARTX, bf16_t* P) {
    PHASE_IDS
    LAS float* rsl = (LAS float*)F.lds3;
    for (int i = 0; ; ++i) { pg8::Unit u; if (!S.next(i, u)) break;
        const int rt = u.pm * 256, g = u.pn; int sbase, Ls;
        if (rt < NLAT) { sbase = rt & ~(L - 1); Ls = L; } else { sbase = NLAT + ((rt - NLAT) & ~(LC - 1)); Ls = LC; }
        __syncthreads();
        if (tid < 272) { const int rr = rt - 8 + tid; float rsv = 0.f;
            if (rr >= sbase && rr < sbase + Ls) { const f32x4 q = *(const f32x4*)(PARTX + (size_t)rr * 4);
                rsv = rsqrtf(((q[0] + q[1]) + (q[2] + q[3])) * (1.f / D) + EPS); }
            rsl[tid] = rsv; }
        __syncthreads();
        const int c = g * 256 + lane * 4;
#pragma unroll 1
        for (int k = 0; k < 2; ++k) { const int rb = wave + 8 * k;
            if (g == 0) pool_rows<2>(Hs, rsl, P, rt, rb, c, sbase, Ls);
            else if (g == 1) pool_rows<4>(Hs, rsl, P, rt, rb, c, sbase, Ls);
            else if (g == 2) pool_rows<8>(Hs, rsl, P, rt, rb, c, sbase, Ls);
            else pool_rows<16>(Hs, rsl, P, rt, rb, c, sbase, Ls); }
    }
    asm volatile("s_waitcnt vmcnt(0)" ::: "memory");
    __syncthreads();
}

__device__ __forceinline__ void final_fused(const Frame& F, const pg8::StreamOrder& S, const float* fnw) {
    PHASE_IDS
    pg8::Unit u; if (!S.next(0, u)) return;
    const int rt = u.pm * 256, c0 = u.pn * 256;
    LAS float* rsl = (LAS float*)F.lds3;
    asm volatile("s_waitcnt vmcnt(0)" ::: "memory"); __syncthreads();
    if (tid == 0) { unsigned* cw = (unsigned*)(F.ws + WS_ZERO) + u.pm * 16; __hip_atomic_fetch_add(cw, 1u, __ATOMIC_RELAXED, __HIP_MEMORY_SCOPE_AGENT); unsigned sp = 0;
        while (__hip_atomic_load(cw, __ATOMIC_RELAXED, __HIP_MEMORY_SCOPE_AGENT) < 4u) { __builtin_amdgcn_s_sleep(1); if (++sp > (1u << 22)) break; }
        __builtin_amdgcn_fence(__ATOMIC_ACQUIRE, "agent"); }
    __syncthreads();
    if (tid < 256) { const f32x4 q = *(const f32x4*)(WSP(float, WS_PARTX) + (size_t)(rt + tid) * 4); rsl[tid] = rsqrtf(((q[0] + q[1]) + (q[2] + q[3])) * (1.f / D) + EPS); }
    __syncthreads();
    const bf16_t* XB = WSP(bf16_t, WS_XB); const f32x4 fw = *(const f32x4*)(fnw + c0 + lane * 4);
#pragma unroll 1
    for (int rb = 0; rb < 2; ++rb) {
        u32x2 w[16];
#pragma unroll
        for (int i = 0; i < 16; ++i) w[i] = *(const u32x2*)(XB + (size_t)(rt + wave + NWAVES * (16 * rb + i)) * RP + c0 + lane * 4);
#pragma unroll
        for (int i = 0; i < 16; ++i) { const int r = wave + NWAVES * (16 * rb + i);
            __builtin_nontemporal_store(unpkh4(w[i]) * rsl[r] * fw, (f32x4*)(F.X + (size_t)(rt + r) * D + c0 + lane * 4)); }
    }
}

__global__ void __launch_bounds__(NT, 2) fwd_kernel(Params p) {
    extern __shared__ __attribute__((aligned(16))) unsigned char lds_raw[];
    cg::grid_group grid = cg::this_grid();
    Frame F;
    F.ws = p.ws; F.X = p.out;
    F.lds3 = (LAS unsigned char*)lds_raw; F.lds = (float*)lds_raw;
    const int G = gridDim.x, bid = blockIdx.x;
    for (int u = threadIdx.x; u < (LDS_BYTES - LDSCTL_OFF) / 4; u += NT) ((LAS unsigned*)(F.lds3 + LDSCTL_OFF))[u] = 0u;
    __syncthreads();
    volatile LAS unsigned* MISC = (volatile LAS unsigned*)(F.lds3 + MISC_OFF);
    XcdBarrier bar = xcd_barrier_post(WSP(unsigned, WS_CTL) + 1024, MISC + 8);
#define GRID_BAR() xcd_barrier(bar)
    const size_t STD_UNIT = (size_t)256 * RP * 2, STD_HALF = (size_t)128 * RP * 2;

    p0_weights<0>(F, p, (G == 256) ? (((bid & 64) ? 0 : 128) + (bid & 63) + ((bid >> 7) << 6)) : bid, G);
    __syncthreads();
    p0_mod(F, p, 0, bid, G); p0_mod(F, p, 1, (bid + G / 2) % G, G);
    p0_rope(F);
    GRID_BAR();
    p1_prep(F, p);
    GRID_BAR();
    if (p.ws == nullptr) grid.sync();
    for (int layer = 0; layer < DEPTH; ++layer) {
        int lg = G, lb = bid; asm volatile("" : "+s"(lg), "+s"(lb));
        const int kind = layer % 3, j = layer / 3; const bool last = layer == DEPTH - 1;
        const int nrows_res = last ? NLAT : NTOK;
        const float* mod_layer = WSP(float, WS_MOD) + (size_t)layer * 5 * 6144;
        if (kind == 0) {
            { PHASE_IDS const float* rt_ = WSP(float, WS_ROPE); *(LAS f32x4*)(F.lds3 + ROPE_OFF + tid * 16) = *(const f32x4*)(rt_ + tid * 4); }
            { pg8::Gemm g{WSP(bf16_t, WS_H), WSP(bf16_t, WS_WQKV) + (size_t)j * QKVW * RP, RP, RP, D, 0, STD_UNIT, (size_t)16 * RP * 2}; pg8::StaticOrder S; S.init(NTOK, QKVW, lg, lb);
              EpiQKV E{WSP(bf16_t, WS_Q), WSP(bf16_t, WS_K), (WS_V - WS_K) / 2, WSP(float, WS_BIASW) + BW_GAINP + (size_t)j * 256, WSP(float, WS_PARTX), WSP(float, WS_BIASW) + BW_QKV + (size_t)j * 5 * QKVW, (LAS float*)(F.lds3 + PRM_OFF), (const LAS float*)(F.lds3 + ROPE_OFF)};
              pg8::gemm_phase<EpiQKV, pg8::StaticOrder, true>(F.lds3, g, S, E); }
            if (layer == 0) { int fi = (NTOK / 256) * (QKVW / 256) - G; if (fi < 0 || fi >= G) fi = 0;
                if (bid >= fi) { __syncthreads(); p0_weights<1>(F, p, bid - fi, G - fi); } }
            GRID_BAR();
            attn_phase(F, IN(I_QG) + j * HD, IN(I_KG) + j * HD, !last);
            GRID_BAR();
            { pg8::Gemm g{WSP(bf16_t, WS_Q), WSP(bf16_t, WS_WO) + (size_t)j * D * RP, RP, RP, D, 0, STD_UNIT, STD_HALF}; pg8::StreamOrder S0, S; S0.init(nrows_res, D, D, lg, lb, 0); S.init(nrows_res, D, D, lg, lb, 1);
              EpiResid<false> E{WSP(bf16_t, WS_XB), mod_layer, 2, nullptr, nullptr, WSP(bf16_t, WS_H), WSP(float, WS_PARTX), IN(I_NORMW) + (size_t)(layer * 2 + 1) * D, mod_layer, 4, (LAS float*)(F.lds3 + XB_OFF + 2048), (LAS float*)(F.lds3 + PRM_OFF)};
              EpiTailT<EpiResid<false>> ET{WSP(float, WS_BIG1), (unsigned*)(F.ws + WS_SFLAG + (size_t)j * SFLAG_PHASE)}; pg8::gemm_phase<EpiTailT<EpiResid<false>>, pg8::StreamOrder, true>(F.lds3, g, S0, ET);
              EpiHead<EpiResid<false>> ES{E, WSP(float, WS_BIG1), (unsigned*)(F.ws + WS_SFLAG + (size_t)j * SFLAG_PHASE), F.lds3};
              pg8::gemm_phase<EpiHead<EpiResid<false>>, pg8::StreamOrder, true>(F.lds3, g, S, ES); }
            GRID_BAR();
        } else if (kind == 1) {
            { pg8::Gemm g{WSP(bf16_t, WS_BIG2), WSP(bf16_t, WS_WPOOL), RP, RPP, 256, (size_t)256 * 2, (size_t)256 * RPP * 2, (size_t)128 * RPP * 2}; pg8::StaticOrder S; S.init(nrows_res, D, lg, lb);
              pool_prep_units(F, S, WSP(bf16_t, WS_H), WSP(float, WS_PARTX), WSP(bf16_t, WS_BIG2));
              EpiResid<true> E{WSP(bf16_t, WS_XB), mod_layer, 2, IN(I_POOLB) + (size_t)j * D, IN(I_POOLS) + (size_t)j * D, WSP(bf16_t, WS_H), WSP(float, WS_PARTX), IN(I_NORMW) + (size_t)(layer * 2 + 1) * D, mod_layer, 4, (LAS float*)(F.lds3 + XB_OFF + 2048), (LAS float*)(F.lds3 + PRM_OFF)};
              pg8::gemm_phase<EpiResid<true>, pg8::StaticOrder, true>(F.lds3, g, S, E); }
            { const int nwg_ = (nrows_res / 256) * 4; int fi = nwg_ - ((nwg_ - 1) / G) * G; if (fi < 0 || fi >= G) fi = 0;
              if (bid >= fi && layer + 1 < DEPTH) { __syncthreads(); p0_mod(F, p, layer + 1, bid - fi, G - fi); __syncthreads(); p0_weights<3>(F, p, bid - fi, G - fi); } }
            GRID_BAR();
        } else {
            { pg8::Gemm g{WSP(bf16_t, WS_H), WSP(bf16_t, WS_WIN), RP, RP, D, 0, STD_UNIT, STD_HALF}; pg8::StaticOrder S; S.init(nrows_res, 2048, lg, lb);
              EpiGelu E{WSP(bf16_t, WS_SU), WSP(bf16_t, WS_SV), WSP(float, WS_SPART), WSP(float, WS_PARTX), WSP(float, WS_BIASW) + BW_WIN, (LAS float*)(F.lds3 + PRM_OFF)}; pg8::gemm_phase<EpiGelu, pg8::StaticOrder, true>(F.lds3, g, S, E); }
            { const int nwg_ = (nrows_res / 256) * 8; int fi = nwg_ - ((nwg_ - 1) / G) * G; if (fi < 0 || fi >= G) fi = 0;
              if (bid >= fi && layer + 1 < DEPTH) { __syncthreads(); p0_mod(F, p, layer + 1, bid - fi, G - fi); __syncthreads(); p0_weights<4>(F, p, bid - fi, G - fi); } }
            GRID_BAR();
            sgu_spatial(F, IN(I_SWS) + (size_t)j * 8 * 16384, IN(I_SBS) + (size_t)j * 8 * 128, IN(I_SVG) + (size_t)j * D, WSP(bf16_t, WS_SU), WSP(bf16_t, WS_SV), WSP(float, WS_SPART), WSP(bf16_t, WS_BIG2), nrows_res);
            GRID_BAR();
            { pg8::Gemm g{WSP(bf16_t, WS_BIG2), WSP(bf16_t, WS_WOUT), RP, RP, D, 0, STD_UNIT, STD_HALF}; pg8::StreamOrder S0, S; S0.init(nrows_res, D, D, lg, lb, 0); S.init(nrows_res, D, D, lg, lb, 1);
              EpiResid<false> E{WSP(bf16_t, WS_XB), mod_layer, 2, nullptr, nullptr, WSP(bf16_t, WS_H), WSP(float, WS_PARTX), IN(I_NORMW) + (size_t)(layer * 2 + 1) * D, mod_layer, 4, (LAS float*)(F.lds3 + XB_OFF + 2048), (LAS float*)(F.lds3 + PRM_OFF)};
              EpiTailT<EpiResid<false>> ET{WSP(float, WS_BIG1), (unsigned*)(F.ws + WS_SFLAG + (size_t)2 * SFLAG_PHASE)}; pg8::gemm_phase<EpiTailT<EpiResid<false>>, pg8::StreamOrder, true>(F.lds3, g, S0, ET);
              EpiHead<EpiResid<false>> ES{E, WSP(float, WS_BIG1), (unsigned*)(F.ws + WS_SFLAG + (size_t)2 * SFLAG_PHASE), F.lds3};
              pg8::gemm_phase<EpiHead<EpiResid<false>>, pg8::StreamOrder, true>(F.lds3, g, S, ES); }
            GRID_BAR();
        }
        const bool fuse_fin = last && G * 256 == NLAT * 4;
        { pg8::Gemm g{WSP(bf16_t, WS_H), WSP(bf16_t, WS_WUP) + (size_t)layer * FF2 * RP, RP, RP, D, 0, (size_t)128 * RP * 2, (size_t)FF * RP * 2}; pg8::StaticOrder S; S.init(nrows_res, FF2, lg, lb);
          EpiUpConv E{WSP(bf16_t, WS_BIG1), WSP(float, WS_EDGE), WSP(float, WS_BIASW) + BW_CONVP + (size_t)layer * 22 * 1024, (LAS float*)(F.lds3 + XB_OFF), WSP(float, WS_PARTX), WSP(float, WS_BIASW) + BW_UP + (size_t)layer * 5 * FF2, (LAS float*)(F.lds3 + PRM_OFF)};
          pg8::gemm_phase<EpiUpConv, pg8::StaticOrder, true>(F.lds3, g, S, E); }
        if (!last) { const int nwg_ = (nrows_res / 256) * 22; int fi = nwg_ - ((nwg_ - 1) / G) * G; if (fi < 0 || fi >= G) fi = 0;
            if (bid >= fi) { __syncthreads(); if (layer == 0) { bias_gemv<1>(F, bid - fi, G - fi); p0_weights<2>(F, p, bid - fi, G - fi); } else if (layer == 1) bias_gemv<2>(F, bid - fi, G - fi); else bias_gemv<3>(F, bid - fi, G - fi); } }
        GRID_BAR();
        ffn_fixup(F, IN(I_CONVW) + (size_t)layer * 3 * FF2, IN(I_CONVB) + (size_t)layer * FF2, WSP(float, WS_EDGE), WSP(bf16_t, WS_BIG1));
        GRID_BAR();
        { pg8::Gemm g{WSP(bf16_t, WS_BIG1), WSP(bf16_t, WS_WDN) + (size_t)layer * D * FF, FF, FF, FF, 0, (size_t)256 * FF * 2, (size_t)128 * FF * 2}; pg8::StreamOrder S0, S; S0.init(nrows_res, D, FF, lg, lb, 0); S.init(nrows_res, D, FF, lg, lb, 1);
          EpiResid<false, true> E{WSP(bf16_t, WS_XB), mod_layer, 5, nullptr, nullptr, last ? nullptr : WSP(bf16_t, WS_H), WSP(float, WS_PARTX), IN(I_NORMW) + (size_t)((layer + 1) * 2) * D, WSP(float, WS_MOD) + (size_t)(layer + 1) * 5 * 6144, fuse_fin ? 99 : 1, (LAS float*)(F.lds3 + XB_OFF + 2048), (LAS float*)(F.lds3 + PRM_OFF)};
          EpiTailT<EpiResid<false, true>> ET{WSP(float, WS_BIG2), (unsigned*)(F.ws + WS_SFLAG + (size_t)(3 + layer) * SFLAG_PHASE)}; pg8::gemm_phase<EpiTailT<EpiResid<false, true>>, pg8::StreamOrder, true>(F.lds3, g, S0, ET);
              EpiHead<EpiResid<false, true>> ES{E, WSP(float, WS_BIG2), (unsigned*)(F.ws + WS_SFLAG + (size_t)(3 + layer) * SFLAG_PHASE), F.lds3};
              pg8::gemm_phase<EpiHead<EpiResid<false, true>>, pg8::StreamOrder, true>(F.lds3, g, S, ES);
              if (fuse_fin) { final_fused(F, S, IN(I_FNORM)); return; } }
        GRID_BAR();
    }
    final_norm(F, IN(I_FNORM));
}

extern "C" void kernel_launch(void* const* d_in, const int* in_sizes, int n_in, void* d_out, int out_size, void* d_ws, size_t ws_size, hipStream_t stream) {
    constexpr size_t kDynLds = LDS_BYTES;
    static int grid_blocks = 0;
    if (!grid_blocks) {
        int dev = 0, cus = 0, per_cu = 0;
        (void)hipGetDevice(&dev);
        (void)hipDeviceGetAttribute(&cus, hipDeviceAttributeMultiprocessorCount, dev);
        (void)hipFuncSetAttribute((const void*)fwd_kernel, hipFuncAttributeMaxDynamicSharedMemorySize, (int)kDynLds);
        (void)hipOccupancyMaxActiveBlocksPerMultiprocessor(&per_cu, fwd_kernel, NT, kDynLds);
        if (per_cu < 1) fprintf(stderr, "occupancy query returned %d\n", per_cu);
        grid_blocks = cus;
        if (ws_size < WS_END) fprintf(stderr, "workspace too small: %zu < %zu\n", ws_size, (size_t)WS_END);
    }
    (void)hipMemsetAsync((char*)d_ws + WS_CTL, 0, CTL_ZERO_BYTES, stream);
    Params p{};
    for (int i = 0; i < 24; ++i) p.in[i] = (const float*)d_in[i];
    p.out = (float*)d_out; p.ws = (unsigned char*)d_ws;
    void* args[] = {&p};
    hipError_t e = hipLaunchCooperativeKernel((void*)fwd_kernel, dim3(grid_blocks), dim3(NT), args, kDynLds, stream);
    if (e != hipSuccess) fprintf(stderr, "cooperative launch failed: %s (grid %d)\n", hipGetErrorString(e), grid_blocks);
}
```
